# Optimizing an MI355X kernel written in HIP

```python
import math
import jax
import jax.numpy as jnp
from jax import lax
import numpy as np

D_MODEL = 2048
BATCH = 16
SEQ = 2048
DEPTH = 2

CHUNK = 64
N_EVEN = (DEPTH + 1) // 2
N_ODD = DEPTH // 2
EPS = 1e-6

SGU_BLOCK = 128
WA = D_MODEL // 2
A_HEADS = 8
A_HEAD_DIM = WA // A_HEADS
WB = D_MODEL // 2
POOL_WINDOWS = (2, 4, 8, 16)
B_GROUPS = len(POOL_WINDOWS)
GB = WB // B_GROUPS
WC = D_MODEL // 2
SHORT_CONV = 3
WD = D_MODEL // 2
CONF_CONV = 31
N_EXPERTS = 64
TOP_K = 6
N_GROUPS = 8
TOPK_GROUPS = 4
EXPERT_FF = 384
SHARED_FF = D_MODEL // 4
ROUTED_SCALE = 2.5
MOE_BLOCK = 512

kernel_name = "hybrid_chunk_causal_sgu_pool_conv_moe"


def rmsnorm(x, g):
    xf = x.astype(jnp.float32)
    y = xf * lax.rsqrt(jnp.mean(xf * xf, axis=-1, keepdims=True) + EPS)
    return (y * g.astype(jnp.float32)).astype(x.dtype)


def layernorm(x, g, b):
    xf = x.astype(jnp.float32)
    mu = jnp.mean(xf, axis=-1, keepdims=True)
    var = jnp.mean(jnp.square(xf - mu), axis=-1, keepdims=True)
    y = (xf - mu) * lax.rsqrt(var + EPS)
    return (y * g.astype(jnp.float32) + b.astype(jnp.float32)).astype(x.dtype)


def causal_dwconv(x, w, b):
    k = w.shape[0]
    y = lax.conv_general_dilated(x, w[:, None, :].astype(x.dtype), window_strides=(1,),
                                 padding=[(k - 1, 0)], dimension_numbers=("NWC", "WIO", "NWC"),
                                 feature_group_count=x.shape[-1])
    return y + b.astype(x.dtype)


def mixer_ab(h, w_in, sgu_ln_g, sgu_ln_b, sgu_w, sgu_b, pool_w, pool_scale, w_out):
    bsz, seq, _ = h.shape
    p = h @ w_in
    u, v, xb = p[..., :WA], p[..., WA:2 * WA], p[..., 2 * WA:]
    v = layernorm(v, sgu_ln_g, sgu_ln_b)
    vb = v.reshape(bsz, seq // SGU_BLOCK, SGU_BLOCK, A_HEADS, A_HEAD_DIM)
    cidx = jnp.arange(SGU_BLOCK) // CHUNK
    mask = cidx[:, None] >= cidx[None, :]
    ws = jnp.where(mask[None], sgu_w, jnp.zeros_like(sgu_w))
    s = jnp.einsum("hij,bnjhd->bnihd", ws, vb) + jnp.transpose(sgu_b)[None, None, :, :, None]
    ya = u * s.reshape(bsz, seq, WA)
    xf = xb.astype(jnp.float32)
    cs0 = jnp.concatenate([jnp.zeros((bsz, 1, WB), jnp.float32), jnp.cumsum(xf, axis=1)], axis=1)
    pos_count = jnp.arange(1, seq + 1, dtype=jnp.float32)
    groups = []
    for gi, win in enumerate(POOL_WINDOWS):
        sl = cs0[..., gi * GB:(gi + 1) * GB]
        upper = sl[:, 1:]
        lower = jnp.pad(sl[:, :seq - win + 1], ((0, 0), (win - 1, 0), (0, 0)))
        cnt = jnp.minimum(pos_count, float(win))[None, :, None]
        groups.append((upper - lower) / cnt - xf[..., gi * GB:(gi + 1) * GB])
    pooled = jnp.stack(groups, axis=2).astype(xb.dtype)
    yb = jnp.einsum("bsgc,gcd->bsgd", pooled, pool_w).reshape(bsz, seq, WB) * pool_scale
    return jnp.concatenate([ya, yb], axis=-1) @ w_out


def mixer_cd(h, w_in, conv3_w, conv3_b, conv31_w, conv31_b, ln_g, ln_b, w_out):
    p = h @ w_in
    bg = p[..., :WC]
    cg = p[..., WC:2 * WC]
    xc = p[..., 2 * WC:3 * WC]
    da = p[..., 3 * WC:3 * WC + WD]
    dg = p[..., 3 * WC + WD:]
    yc = bg * causal_dwconv(cg * xc, conv3_w, conv3_b)
    d = da * jax.nn.sigmoid(dg)
    d = causal_dwconv(d, conv31_w, conv31_b)
    d = jax.nn.silu(layernorm(d, ln_g, ln_b))
    return jnp.concatenate([yc, d], axis=-1) @ w_out


def moe(h, router_w, router_b, w1, w3, w2, sw1, sw3, sw2):
    bsz, seq, dm = h.shape
    xt = h.reshape(-1, dm)
    n = xt.shape[0]
    nk = n * TOP_K
    scores = jax.nn.sigmoid((xt @ router_w).astype(jnp.float32))
    choice = scores + router_b.astype(jnp.float32)
    grp = choice.reshape(n, N_GROUPS, N_EXPERTS // N_GROUPS)
    grp_score = lax.top_k(grp, 2)[0].sum(-1)
    _, gidx = lax.top_k(grp_score, TOPK_GROUPS)
    gmask = jax.nn.one_hot(gidx, N_GROUPS, dtype=jnp.float32).sum(1) > 0
    emask = jnp.repeat(gmask, N_EXPERTS // N_GROUPS, axis=1)
    masked = jnp.where(emask, choice, -jnp.inf)
    _, eidx = lax.top_k(masked, TOP_K)
    wts = jnp.take_along_axis(scores, eidx, axis=1)
    wts = wts / jnp.sum(wts, axis=-1, keepdims=True) * ROUTED_SCALE
    flat_e = eidx.reshape(-1)
    order = jnp.argsort(flat_e)
    sorted_e = flat_e[order]
    tok = order // TOP_K
    counts = jnp.bincount(flat_e, length=N_EXPERTS).astype(jnp.int32)
    pcounts = (counts + MOE_BLOCK - 1) // MOE_BLOCK * MOE_BLOCK
    offs = jnp.cumsum(counts) - counts
    pends = jnp.cumsum(pcounts)
    poffs = pends - pcounts
    dest = poffs[sorted_e] + (jnp.arange(nk, dtype=jnp.int32) - offs[sorted_e])
    nb = -(-nk // MOE_BLOCK) + N_EXPERTS
    xbuf = jnp.zeros((nb * MOE_BLOCK, dm), xt.dtype).at[dest].set(xt[tok])
    block_e = jnp.minimum(jnp.searchsorted(pends, jnp.arange(nb, dtype=jnp.int32) * MOE_BLOCK,
                                           side="right"), N_EXPERTS - 1)
    xb = xbuf.reshape(nb, MOE_BLOCK, dm)
    a = jax.nn.silu(jnp.einsum("brd,bdf->brf", xb, w1[block_e])) * \
        jnp.einsum("brd,bdf->brf", xb, w3[block_e])
    yb = jnp.einsum("brf,bfd->brd", a, w2[block_e]).reshape(-1, dm)
    y = yb[dest] * wts.reshape(-1)[order][:, None].astype(yb.dtype)
    routed = jax.ops.segment_sum(y, tok, num_segments=n)
    shared = (jax.nn.silu(xt @ sw1) * (xt @ sw3)) @ sw2
    return (routed + shared).reshape(bsz, seq, dm)


def setup_inputs(seed: int = 0) -> dict:
    key = jax.random.key(seed)
    keys = iter(jax.random.split(key, 48))

    def nrm(shape, scale):
        return jax.random.normal(next(keys), shape, jnp.float32) * scale

    def gain(shape):
        return 1.0 + nrm(shape, 0.05)

    d = D_MODEL
    return {
        "x": nrm((BATCH, SEQ, d), 1.0),
        "c": nrm((BATCH, d), 1.0),
        "ada_w": nrm((DEPTH, d, 6 * d), 0.5 * d ** -0.5),
        "ada_b": nrm((DEPTH, 6 * d), 0.02),
        "norm_mix_g": gain((DEPTH, d)),
        "norm_ffn_g": gain((DEPTH, d)),
        "ab_w_in": nrm((N_EVEN, d, 2 * WA + WB), d ** -0.5),
        "sgu_ln_g": gain((N_EVEN, WA)),
        "sgu_ln_b": nrm((N_EVEN, WA), 0.02),
        "sgu_w": nrm((N_EVEN, A_HEADS, SGU_BLOCK, SGU_BLOCK), SGU_BLOCK ** -0.5),
        "sgu_b": gain((N_EVEN, A_HEADS, SGU_BLOCK)),
        "pool_w": nrm((N_EVEN, B_GROUPS, GB, GB), GB ** -0.5),
        "pool_scale": gain((N_EVEN, WB)),
        "ab_w_out": nrm((N_EVEN, WA + WB, d), (WA + WB) ** -0.5),
        "cd_w_in": nrm((N_ODD, d, 3 * WC + 2 * WD), d ** -0.5),
        "conv3_w": nrm((N_ODD, SHORT_CONV, WC), SHORT_CONV ** -0.5),
        "conv3_b": nrm((N_ODD, WC), 0.02),
        "conv31_w": nrm((N_ODD, CONF_CONV, WD), CONF_CONV ** -0.5),
        "conv31_b": nrm((N_ODD, WD), 0.02),
        "cd_ln_g": gain((N_ODD, WD)),
        "cd_ln_b": nrm((N_ODD, WD), 0.02),
        "cd_w_out": nrm((N_ODD, WC + WD, d), (WC + WD) ** -0.5),
        "router_w": nrm((DEPTH, d, N_EXPERTS), d ** -0.5),
        "router_b": nrm((DEPTH, N_EXPERTS), 0.01),
        "exp_w1": nrm((DEPTH, N_EXPERTS, d, EXPERT_FF), d ** -0.5),
        "exp_w3": nrm((DEPTH, N_EXPERTS, d, EXPERT_FF), d ** -0.5),
        "exp_w2": nrm((DEPTH, N_EXPERTS, EXPERT_FF, d), EXPERT_FF ** -0.5),
        "sh_w1": nrm((DEPTH, d, SHARED_FF), d ** -0.5),
        "sh_w3": nrm((DEPTH, d, SHARED_FF), d ** -0.5),
        "sh_w2": nrm((DEPTH, SHARED_FF, d), SHARED_FF ** -0.5),
        "final_g": gain((d,)),
    }


def reference(x, c, ada_w, ada_b, norm_mix_g, norm_ffn_g,
              ab_w_in, sgu_ln_g, sgu_ln_b, sgu_w, sgu_b, pool_w, pool_scale, ab_w_out,
              cd_w_in, conv3_w, conv3_b, conv31_w, conv31_b, cd_ln_g, cd_ln_b, cd_w_out,
              router_w, router_b, exp_w1, exp_w3, exp_w2, sh_w1, sh_w3, sh_w2, final_g):
    c_act = jax.nn.silu(c)
    for l in range(DEPTH):
        mod = c_act @ ada_w[l] + ada_b[l]
        sh1, sc1, g1, sh2, sc2, g2 = [m[:, None, :] for m in jnp.split(mod, 6, axis=-1)]
        h = rmsnorm(x, norm_mix_g[l]) * (1.0 + sc1) + sh1
        if l % 2 == 0:
            e = l // 2
            mix = mixer_ab(h, ab_w_in[e], sgu_ln_g[e], sgu_ln_b[e], sgu_w[e], sgu_b[e],
                           pool_w[e], pool_scale[e], ab_w_out[e])
        else:
            o = l // 2
            mix = mixer_cd(h, cd_w_in[o], conv3_w[o], conv3_b[o], conv31_w[o], conv31_b[o],
                           cd_ln_g[o], cd_ln_b[o], cd_w_out[o])
        x = x + g1 * mix
        h = rmsnorm(x, norm_ffn_g[l]) * (1.0 + sc2) + sh2
        x = x + g2 * moe(h, router_w[l], router_b[l], exp_w1[l], exp_w3[l], exp_w2[l],
                         sh_w1[l], sh_w3[l], sh_w2[l])
    return rmsnorm(x, final_g)
```

```cpp
#include <hip/hip_runtime.h>
#include <cstdio>
#include <cstdint>

#ifndef N_LAUNCH_MODE
#define N_LAUNCH_MODE 1
#endif

#define LAS __attribute__((address_space(3)))
typedef unsigned short bf16_t;
typedef short bf16x8 __attribute__((ext_vector_type(8)));
typedef short bf16x4 __attribute__((ext_vector_type(4)));
typedef float f32x4 __attribute__((ext_vector_type(4)));
typedef float f32x2 __attribute__((ext_vector_type(2)));
typedef unsigned u32x4 __attribute__((ext_vector_type(4)));
typedef unsigned u32x2 __attribute__((ext_vector_type(2)));

constexpr int DM = 2048, NB = 16, SEQ = 2048, NTOK = NB * SEQ;
constexpr int NE = 64, TOPK = 6, EFF = 384, SFF = 512;
constexpr int NSLOT = NTOK * TOPK;
constexpr int MAXROWS = NSLOT + NE * 256;
constexpr int MAXTILES = MAXROWS / 256;
constexpr float EPS = 1e-6f;

constexpr size_t MiB = 1u << 20;
constexpr size_t WS_CTL = 0, CTL_BYTES = 1 * MiB;
constexpr size_t WS_MODP = 1 * MiB;
constexpr size_t WS_MODF = 7 * MiB;
constexpr size_t WS_WABIN = 9 * MiB;
constexpr size_t WS_WABOUT = 21 * MiB;
constexpr size_t WS_WCDIN = 29 * MiB;
constexpr size_t WS_WCDOUT = 49 * MiB;
constexpr size_t WS_WSH1 = 57 * MiB;
constexpr size_t WS_WSH2 = 67 * MiB;
constexpr size_t WS_WSGU = 71 * MiB;
constexpr size_t WS_WPOOL = 71 * MiB + 512 * 1024;
constexpr size_t WS_WE13 = 72 * MiB;
constexpr size_t WS_WE2 = 264 * MiB;
constexpr size_t WS_H = 360 * MiB;
constexpr size_t WS_SACT = 488 * MiB;
constexpr size_t WS_LOGIT = 520 * MiB;
constexpr size_t WS_ROUTE = 528 * MiB;
constexpr size_t WS_R = 534 * MiB;
constexpr size_t WS_P = WS_R, WS_Y = WS_R + 320 * MiB;
constexpr size_t WS_ACT = WS_R, WS_YBUF = WS_R + 156 * MiB;
constexpr size_t WS_END = WS_R + 924 * MiB;
constexpr size_t RT_TSE = WS_ROUTE, RT_TSR = RT_TSE + (size_t)NSLOT * 4, RT_TSW = RT_TSR + (size_t)NSLOT * 4;
constexpr size_t RT_ROWTOK = RT_TSW + (size_t)NSLOT * 4, RT_ROWDST = RT_ROWTOK + (size_t)MAXROWS * 4, RT_ROWW = RT_ROWDST + (size_t)MAXROWS * 4;
constexpr size_t RT_TILEE = RT_ROWW + (size_t)MAXROWS * 4;
static_assert(RT_TILEE + 4096 <= WS_R, "route map");
constexpr int CW_BAR = 4096;
constexpr int CW_GCNT = 16384;
constexpr int CW_NTILES = 16384 + 256;

constexpr int RING_BYTES = 131072;
constexpr int MISC_OFF = RING_BYTES;
constexpr int LDS_BYTES = 147456;

__device__ __forceinline__ unsigned cvt_pk_bf16(float lo, float hi) { unsigned r; asm volatile("v_cvt_pk_bf16_f32 %0, %1, %2" : "=v"(r) : "v"(lo), "v"(hi)); return r; }
__device__ __forceinline__ float bf_lo(unsigned w) { return __builtin_bit_cast(float, w << 16); }
__device__ __forceinline__ float bf_hi(unsigned w) { return __builtin_bit_cast(float, w & 0xffff0000u); }
__device__ __forceinline__ float fast_sigmoid(float x) { return __builtin_amdgcn_rcpf(1.0f + __builtin_amdgcn_exp2f(-1.44269504f * x)); }
__device__ __forceinline__ float fast_silu(float x) { return x * fast_sigmoid(x); }
__device__ __forceinline__ float wave_sum(float v) {
#pragma unroll
    for (int o = 1; o < 64; o <<= 1) v += __shfl_xor(v, o);
    return v;
}
#define LDS_WAIT() asm volatile("s_waitcnt lgkmcnt(0)" ::: "memory")
#define VM_WAIT() asm volatile("s_waitcnt vmcnt(0)" ::: "memory")

#define XB_TMO      128
#define XB_XCNT(j)  (256  + 64 * (j))
#define XB_XSUB(j)  (1280 + 64 * (j))
#define XB_XGEN(j)  (2304 + 64 * (j))
#define XB_TOP      3328
#define XB_TOPGEN   3392
#define XCD_BAR_WORDS 3456
#define XB_SPIN_CAP (1u << 20)
__device__ __forceinline__ unsigned xb_ld(unsigned* p)              { return __hip_atomic_load(p, __ATOMIC_RELAXED, __HIP_MEMORY_SCOPE_AGENT); }
__device__ __forceinline__ unsigned xb_add(unsigned* p, unsigned v) { return __hip_atomic_fetch_add(p, v, __ATOMIC_RELAXED, __HIP_MEMORY_SCOPE_AGENT); }
__device__ __forceinline__ unsigned xb_xcc_id() { return (unsigned)__builtin_amdgcn_s_getreg((3 << 11) | 20) & 0xFu; }
#define XB_SPIN(cond, bar) do { unsigned _sp = 0; while (cond) { __builtin_amdgcn_s_sleep(1); \
    if ((++_sp & 255u) == 0u) { if (xb_ld(&(bar)[XB_TMO])) break; if (_sp > XB_SPIN_CAP) { atomicAdd(&(bar)[XB_TMO], 1u); break; } } } } while (0)
struct XcdBarrier { unsigned* bar; unsigned x; volatile LAS unsigned* st; };
__device__ __forceinline__ XcdBarrier xcd_barrier_post(unsigned* bar, volatile LAS unsigned* st) {
    XcdBarrier b; b.bar = bar; b.x = xb_xcc_id(); b.st = st;
    if (threadIdx.x == 0) (void)xb_add(&bar[XB_XCNT(b.x)], 1u);
    return b;
}
__device__ __forceinline__ void xcd_barrier_complete(unsigned* bar, unsigned x, unsigned& nloc, unsigned& nx) {
    const unsigned G = gridDim.x * gridDim.y * gridDim.z;
    unsigned sum, cnt, mine, sp = 0u;
    for (;;) {
        sum = 0u; cnt = 0u; mine = 0u;
#pragma unroll
        for (unsigned j = 0; j < 16; ++j) { const unsigned c = xb_ld(&bar[XB_XCNT(j)]); sum += c; cnt += (c > 0u) ? 1u : 0u; mine = (j == x) ? c : mine; }
        if (sum == G) break;
        __builtin_amdgcn_s_sleep(1);
        if ((++sp & 255u) == 0u) { if (xb_ld(&bar[XB_TMO])) break; if (sp > XB_SPIN_CAP) { atomicAdd(&bar[XB_TMO], 1u); break; } }
    }
    nloc = mine > 0u ? mine : 1u; nx = cnt > 0u ? cnt : 1u;
}
__device__ __forceinline__ void xcd_barrier(const XcdBarrier& b) {
    asm volatile("s_waitcnt vmcnt(0)" ::: "memory");
    __syncthreads();
    if (threadIdx.x == 0) {
        unsigned* bar = b.bar;
        __builtin_amdgcn_s_waitcnt(0);
        unsigned nloc = b.st[0], nx = b.st[1];
        if (nloc == 0u) { xcd_barrier_complete(bar, b.x, nloc, nx); b.st[0] = nloc; b.st[1] = nx; }
        const unsigned old = xb_add(&bar[XB_XSUB(b.x)], 1u);
        const unsigned gen = old / nloc;
        if (old + 1u == (gen + 1u) * nloc) {
            __builtin_amdgcn_fence(__ATOMIC_RELEASE, "agent");
            asm volatile("s_waitcnt vmcnt(0)" ::: "memory");
            const unsigned og = xb_add(&bar[XB_TOP], 1u);
            const unsigned tg = og / nx;
            if (og + 1u == (tg + 1u) * nx) xb_add(&bar[XB_TOPGEN], 1u);
            else XB_SPIN(xb_ld(&bar[XB_TOPGEN]) == tg, bar);
            __builtin_amdgcn_fence(__ATOMIC_ACQUIRE, "agent");
            xb_add(&bar[XB_XGEN(b.x)], 1u);
            asm volatile("s_waitcnt vmcnt(0)" ::: "memory");
        } else {
            XB_SPIN(xb_ld(&bar[XB_XGEN(b.x)]) == gen, bar);
            __builtin_amdgcn_fence(__ATOMIC_ACQUIRE, "agent");
            asm volatile("s_waitcnt vmcnt(0)" ::: "memory");
        }
    }
    __syncthreads();
}

namespace pg8 {
constexpr int BM = 256, BK = 64, HALF = 128, HTB = HALF * BK * 2, STAGE_BYTES = 8 * HTB, NXCD = 8, WGM = 8;
__host__ __device__ __forceinline__ int lds_byte(int r, int c) { const int st = (r >> 4) * 2 + (c >> 5), rr = r & 15, cc = c & 31, ob = rr * 64 + cc * 2; return st * 1024 + (ob ^ (((ob >> 9) & 1) << 5)); }
__host__ __device__ __forceinline__ void stage_rc(int b, int& R, int& C) { const int st = b / 1024, sb = b % 1024, swz = sb ^ (((sb >> 9) & 1) << 5); R = (st >> 1) * 16 + swz / 64; C = (st & 1) * 32 + (swz % 64) / 2; }
__host__ __device__ __forceinline__ int perm32(int rho) { const int n = rho >> 4, i = rho & 15; return 8 * (i >> 2) + 4 * n + (i & 3); }

struct Unit { int pm, pn, e; };

__device__ __forceinline__ int xcd_remap(int L, int nwg) { const int q = nwg / NXCD, r = nwg % NXCD, xcd = L % NXCD, off = L / NXCD; return (xcd < r ? xcd * (q + 1) : r * (q + 1) + (xcd - r) * q) + off; }

struct StaticOrder {
    const char* A; const char* Bt; size_t tstep; int nM, nN, nwg, G, c;
    __device__ void init(const bf16_t* A_, const bf16_t* Bt_, int K, int M, int N, int G_, int c_) { A = (const char*)A_; Bt = (const char*)Bt_; tstep = (size_t)BM * K * 2; nM = M / BM; nN = N / BM; nwg = nM * nN; G = G_; c = c_; }
    __device__ __forceinline__ bool next(int i, Unit& u) const {
        const long L = (long)i * G + c; if (L >= nwg) return false;
        const int wgid = xcd_remap((int)L, nwg);
        const int nig = WGM * nN, gid = wgid / nig, fm = gid * WGM, gsz = (nM - fm) < WGM ? (nM - fm) : WGM;
        u.pm = fm + ((wgid % nig) % gsz); u.pn = (wgid % nig) / gsz; u.e = 0; return true;
    }
    __device__ __forceinline__ const char* a_ptr(const Unit& u) const { return A + (size_t)u.pm * tstep; }
    __device__ __forceinline__ const char* b_ptr(const Unit& u) const { return Bt + (size_t)u.pn * tstep; }
    __device__ __forceinline__ const int* rows(const Unit&) const { return nullptr; }
};
struct ExpertOrder {
    const char* A; const char* Bt; const int* tile_e; const int* rowtok; size_t tstep, bstride; int nN, nwg, G, c; bool gather;
    __device__ __forceinline__ bool next(int i, Unit& u) const {
        const long L = (long)i * G + c; if (L >= nwg) return false;
        const int wgid = xcd_remap((int)L, nwg);
        u.pm = wgid / nN; u.pn = wgid % nN;
        u.e = __builtin_amdgcn_readfirstlane(__hip_atomic_load(tile_e + u.pm, __ATOMIC_RELAXED, __HIP_MEMORY_SCOPE_AGENT)); return true;
    }
    __device__ __forceinline__ const char* a_ptr(const Unit& u) const { return gather ? A : A + (size_t)u.pm * tstep; }
    __device__ __forceinline__ const char* b_ptr(const Unit& u) const { return Bt + (size_t)u.e * bstride + (size_t)u.pn * tstep; }
    __device__ __forceinline__ const int* rows(const Unit& u) const { return rowtok + (size_t)u.pm * BM; }
};

struct EpiBf16 {
    static constexpr bool PERM = true;
    bf16_t* O; int ldc;
    __device__ __forceinline__ void operator()(const f32x4 (&acc)[2][2][4][2], const Unit& u, int wr, int wc, int fr, int fq) const {
        const int row0 = u.pm * BM + wr * 64 + fr, col0 = u.pn * BM + wc * 32 + 8 * fq;
#pragma unroll
        for (int ai = 0; ai < 2; ++ai)
#pragma unroll
            for (int m = 0; m < 4; ++m) { bf16_t* rowp = O + (size_t)(row0 + ai * HALF + m * 16) * ldc + col0;
#pragma unroll
                for (int bj = 0; bj < 2; ++bj) { const f32x4 v0 = acc[ai][bj][m][0], v1 = acc[ai][bj][m][1];
                    u32x4 w; w.x = cvt_pk_bf16(v0[0], v0[1]); w.y = cvt_pk_bf16(v0[2], v0[3]); w.z = cvt_pk_bf16(v1[0], v1[1]); w.w = cvt_pk_bf16(v1[2], v1[3]);
                    *(u32x4*)(rowp + bj * HALF) = w; } }
    }
};
struct EpiResGate {
    static constexpr bool PERM = false;
    const float* base; float* out; const float* gate;
    __device__ __forceinline__ void operator()(const f32x4 (&acc)[2][2][4][2], const Unit& u, int wr, int wc, int fr, int fq) const {
        const int row0 = u.pm * BM + wr * 64 + fr, col0 = u.pn * BM + wc * 32 + 4 * fq;
        const float* gp = gate + (size_t)(u.pm >> 3) * DM + col0;
        f32x4 gv[2][2];
#pragma unroll
        for (int bj = 0; bj < 2; ++bj)
#pragma unroll
            for (int n = 0; n < 2; ++n) gv[bj][n] = *(const f32x4*)(gp + bj * HALF + n * 16);
#pragma unroll
        for (int ai = 0; ai < 2; ++ai)
#pragma unroll
            for (int m = 0; m < 4; ++m) { const size_t off = (size_t)(row0 + ai * HALF + m * 16) * DM + col0;
#pragma unroll
                for (int bj = 0; bj < 2; ++bj)
#pragma unroll
                    for (int n = 0; n < 2; ++n) { const f32x4 bs = *(const f32x4*)(base + off + bj * HALF + n * 16);
                        *(f32x4*)(out + off + bj * HALF + n * 16) = bs + gv[bj][n] * acc[ai][bj][m][n]; } }
    }
};
struct EpiSiluMul {
    static constexpr bool PERM = true;
    bf16_t* O; int ldc; float* logits; int router_pn;
    __device__ __forceinline__ void operator()(const f32x4 (&acc)[2][2][4][2], const Unit& u, int wr, int wc, int fr, int fq) const {
        const int row0 = u.pm * BM + wr * 64 + fr, oc = wc * 32 + 8 * fq;
        if (u.pn == router_pn) {
            if (wc < 2) {
#pragma unroll
                for (int ai = 0; ai < 2; ++ai)
#pragma unroll
                    for (int m = 0; m < 4; ++m) { float* rp = logits + (size_t)(row0 + ai * HALF + m * 16) * NE + oc;
                        *(f32x4*)rp = acc[ai][0][m][0]; *(f32x4*)(rp + 4) = acc[ai][0][m][1]; }
            }
            return;
        }
#pragma unroll
        for (int ai = 0; ai < 2; ++ai)
#pragma unroll
            for (int m = 0; m < 4; ++m) { bf16_t* rowp = O + (size_t)(row0 + ai * HALF + m * 16) * ldc + u.pn * HALF + oc;
                float r[8];
#pragma unroll
                for (int n = 0; n < 2; ++n)
#pragma unroll
                    for (int j = 0; j < 4; ++j) r[n * 4 + j] = fast_silu(acc[ai][0][m][n][j]) * acc[ai][1][m][n][j];
                u32x4 w; w.x = cvt_pk_bf16(r[0], r[1]); w.y = cvt_pk_bf16(r[2], r[3]); w.z = cvt_pk_bf16(r[4], r[5]); w.w = cvt_pk_bf16(r[6], r[7]);
                *(u32x4*)rowp = w; }
    }
};
struct EpiScatterY {
    static constexpr bool PERM = true;
    bf16_t* Y; const int* rowdst; const float* roww;
    __device__ __forceinline__ void operator()(const f32x4 (&acc)[2][2][4][2], const Unit& u, int wr, int wc, int fr, int fq) const {
        const int row0 = u.pm * BM + wr * 64 + fr, col0 = u.pn * BM + wc * 32 + 8 * fq;
#pragma unroll
        for (int ai = 0; ai < 2; ++ai)
#pragma unroll
            for (int m = 0; m < 4; ++m) { const int r = row0 + ai * HALF + m * 16; const int dst = rowdst[r]; const float w = roww[r];
                if (dst >= 0) { bf16_t* rowp = Y + (size_t)dst * DM + col0;
#pragma unroll
                    for (int bj = 0; bj < 2; ++bj) { const f32x4 v0 = acc[ai][bj][m][0] * w, v1 = acc[ai][bj][m][1] * w;
                        u32x4 o; o.x = cvt_pk_bf16(v0[0], v0[1]); o.y = cvt_pk_bf16(v0[2], v0[3]); o.z = cvt_pk_bf16(v1[0], v1[1]); o.w = cvt_pk_bf16(v1[2], v1[3]);
                        *(u32x4*)(rowp + bj * HALF) = o; } } }
    }
};
struct EpiCombine {
    static constexpr bool PERM = false;
    const float* base; float* out; const float* gate; const bf16_t* Y;
    __device__ __forceinline__ void operator()(const f32x4 (&acc)[2][2][4][2], const Unit& u, int wr, int wc, int fr, int fq) const {
        const int row0 = u.pm * BM + wr * 64 + fr, col0 = u.pn * BM + wc * 32 + 4 * fq;
        const float* gp = gate + (size_t)(u.pm >> 3) * DM + col0;
        f32x4 gv[2][2];
#pragma unroll
        for (int bj = 0; bj < 2; ++bj)
#pragma unroll
            for (int n = 0; n < 2; ++n) gv[bj][n] = *(const f32x4*)(gp + bj * HALF + n * 16);
#pragma unroll
        for (int ai = 0; ai < 2; ++ai)
#pragma unroll
            for (int m = 0; m < 4; ++m) { const int r = row0 + ai * HALF + m * 16; const size_t off = (size_t)r * DM + col0; const bf16_t* yp = Y + (size_t)r * (TOPK * DM) + col0;
#pragma unroll
                for (int bj = 0; bj < 2; ++bj)
#pragma unroll
                    for (int n = 0; n < 2; ++n) { const int co = bj * HALF + n * 16;
                        f32x4 s = acc[ai][bj][m][n];
#pragma unroll
                        for (int k = 0; k < TOPK; ++k) { const u32x2 y = *(const u32x2*)(yp + (size_t)k * DM + co); s[0] += bf_lo(y.x); s[1] += bf_hi(y.x); s[2] += bf_lo(y.y); s[3] += bf_hi(y.y); }
                        const f32x4 bs = *(const f32x4*)(base + off + co);
                        *(f32x4*)(out + off + co) = bs + gv[bj][n] * s; }
                asm volatile("" ::: "memory"); }
    }
};

template <class Epi, class Sched, int K, bool GATHER>
__device__ __forceinline__ void gemm_phase(LAS unsigned char* lds, const Sched& S, const Epi& E) {
    const int tid = threadIdx.x, wid = __builtin_amdgcn_readfirstlane(tid >> 6), lane = tid & 63, wr = wid >> 2, wc = wid & 3, fr = lane & 15, fq = lane >> 4;
    constexpr int nt = K / BK;
    static_assert(K % 128 == 0 && K >= 256, "K");
    unsigned voffA[2], voffB[2]; int RA[2]; unsigned CA2[2];
#pragma unroll
    for (int i = 0; i < 2; ++i) { int R, C; stage_rc(tid * 16 + i * 8192, R, C); const int Rb = Epi::PERM ? ((R & ~31) + perm32(R & 31)) : R;
        voffA[i] = (unsigned)(R * K + C) * 2u; voffB[i] = (unsigned)(Rb * K + C) * 2u; RA[i] = R; CA2[i] = (unsigned)C * 2u; }
    constexpr size_t kstep = (size_t)(BK * 2);
    constexpr size_t hstep = (size_t)HALF * K * 2;
    const unsigned ldsw = (unsigned)wid * 1024u;
    const int aoff = lds_byte(wr * 64 + fr, fq * 8), boff = lds_byte(wc * 32 + fr, fq * 8);
#define PG8_SA(b, h) (((b) * 2 + (h)) * HTB)
#define PG8_SB(b, h) ((4 + (b) * 2 + (h)) * HTB)
#define PG8_STAGE(bufoff, gbase, voff) do { _Pragma("unroll") for (int _i = 0; _i < 2; ++_i) \
        __builtin_amdgcn_global_load_lds((const unsigned*)((const char*)(gbase) + (voff)[_i]), (LAS unsigned*)(lds + (bufoff) + ldsw + _i * 8192), 16, 0, 0); } while (0)
#define PG8_STAGE_A(bufoff, h, p, go) do { if constexpr (GATHER) { PG8_STAGE(bufoff, p, (go)[h]); } else { PG8_STAGE(bufoff, (p) + (h) * hstep, voffA); } } while (0)
#define PG8_LDA(dst, b, h) do { _Pragma("unroll") for (int m = 0; m < 4; ++m) _Pragma("unroll") for (int k = 0; k < 2; ++k) dst[m][k] = *(const LAS bf16x8*)(lds + PG8_SA(b, h) + aoff + m * 2048 + k * 1024); } while (0)
#define PG8_LDB(dst, b, h) do { _Pragma("unroll") for (int n = 0; n < 2; ++n) _Pragma("unroll") for (int k = 0; k < 2; ++k) dst[n][k] = *(const LAS bf16x8*)(lds + PG8_SB(b, h) + boff + n * 2048 + k * 1024); } while (0)
#define PG8_MMA(ai, bj, At, Bt) do { __builtin_amdgcn_s_setprio(1); _Pragma("unroll") for (int m = 0; m < 4; ++m) _Pragma("unroll") for (int n = 0; n < 2; ++n) _Pragma("unroll") for (int k = 0; k < 2; ++k) \
        acc[ai][bj][m][n] = __builtin_amdgcn_mfma_f32_16x16x32_bf16(Bt[n][k], At[m][k], acc[ai][bj][m][n], 0, 0, 0); __builtin_amdgcn_s_setprio(0); } while (0)
#define PG8_WAIT_V(n) asm volatile("s_waitcnt vmcnt(" #n ")" ::: "memory")
#define PG8_WAIT_L(n) asm volatile("s_waitcnt lgkmcnt(" #n ")" ::: "memory")
#define PG8_BAR __builtin_amdgcn_s_barrier()
#define PG8_SCHED __builtin_amdgcn_sched_barrier(0)
    Unit cur, nxt; int ui = 0;
    if (!S.next(0, cur)) return;
    f32x4 acc[2][2][4][2];
#pragma unroll
    for (int a = 0; a < 2; ++a)
#pragma unroll
        for (int b = 0; b < 2; ++b)
#pragma unroll
            for (int m = 0; m < 4; ++m)
#pragma unroll
                for (int n = 0; n < 2; ++n) acc[a][b][m][n] = (f32x4){0.f, 0.f, 0.f, 0.f};
    bf16x8 At[4][2], B0[2][2], B1[2][2];
    unsigned gcur[2][2] = {{0u, 0u}, {0u, 0u}}, gnxt[2][2] = {{0u, 0u}, {0u, 0u}};
    const char* cA = S.a_ptr(cur); const char* cB = S.b_ptr(cur);
    if constexpr (GATHER) { const int* rl = S.rows(cur);
#pragma unroll
        for (int h = 0; h < 2; ++h)
#pragma unroll
            for (int i = 0; i < 2; ++i) { gcur[h][i] = (unsigned)rl[h * HALF + RA[i]] * (unsigned)(K * 2) + CA2[i]; asm volatile("" : "+v"(gcur[h][i])); } }
    PG8_STAGE(PG8_SB(0, 0), cB, voffB); PG8_STAGE(PG8_SB(0, 1), cB + hstep, voffB); PG8_STAGE_A(PG8_SA(0, 0), 0, cA, gcur); PG8_STAGE_A(PG8_SA(0, 1), 1, cA, gcur);
    if (wr == 1) PG8_BAR;
    PG8_WAIT_V(2); PG8_BAR;
    PG8_STAGE(PG8_SB(1, 0), cB + kstep, voffB); PG8_STAGE_A(PG8_SA(1, 0), 0, cA + kstep, gcur); PG8_STAGE(PG8_SB(1, 1), cB + hstep + kstep, voffB);
    PG8_WAIT_V(6); PG8_BAR;
    for (;;) {
        const bool has_next = S.next(ui + 1, nxt);
        const char* nA = has_next ? S.a_ptr(nxt) : cA; const char* nB = has_next ? S.b_ptr(nxt) : cB;
        if constexpr (GATHER) {
            if (has_next) { const int* rl = S.rows(nxt);
#pragma unroll
                for (int h = 0; h < 2; ++h)
#pragma unroll
                    for (int i = 0; i < 2; ++i) gnxt[h][i] = (unsigned)rl[h * HALF + RA[i]] * (unsigned)(K * 2) + CA2[i];
            } else {
#pragma unroll
                for (int h = 0; h < 2; ++h)
#pragma unroll
                    for (int i = 0; i < 2; ++i) gnxt[h][i] = gcur[h][i];
            }
#pragma unroll
            for (int h = 0; h < 2; ++h)
#pragma unroll
                for (int i = 0; i < 2; ++i) asm volatile("" : "+v"(gnxt[h][i]));
        }
        for (int t = 0; t < nt; t += 2) {
            const bool last = (t == nt - 2);
            const char* a1 = cA + (size_t)(t + 1) * kstep;
            const char* a2 = last ? nA : cA + (size_t)(t + 2) * kstep; const char* b2 = last ? nB : cB + (size_t)(t + 2) * kstep;
            const char* a3 = a2 + kstep; const char* b3 = b2 + kstep;
            unsigned g2[2][2];
#pragma unroll
            for (int h = 0; h < 2; ++h)
#pragma unroll
                for (int i = 0; i < 2; ++i) g2[h][i] = last ? gnxt[h][i] : gcur[h][i];
            PG8_LDB(B0, 0, 0); PG8_LDB(B1, 0, 1); PG8_SCHED; PG8_LDA(At, 0, 0); PG8_STAGE_A(PG8_SA(1, 1), 1, a1, gcur);
            PG8_WAIT_V(8); PG8_WAIT_L(0); PG8_BAR; PG8_MMA(0, 0, At, B0); PG8_MMA(0, 1, At, B1); PG8_BAR; PG8_SCHED;
            PG8_LDA(At, 0, 1); PG8_STAGE(PG8_SB(0, 0), b2, voffB); PG8_STAGE(PG8_SB(0, 1), b2 + hstep, voffB); PG8_STAGE_A(PG8_SA(0, 0), 0, a2, g2);
            PG8_WAIT_V(8); PG8_WAIT_L(0); PG8_BAR; PG8_MMA(1, 0, At, B0); PG8_MMA(1, 1, At, B1); PG8_BAR; PG8_SCHED;
            PG8_LDB(B0, 1, 0); PG8_LDB(B1, 1, 1); PG8_SCHED; PG8_LDA(At, 1, 0); PG8_STAGE_A(PG8_SA(0, 1), 1, a2, g2);
            PG8_WAIT_V(8); PG8_WAIT_L(0); PG8_BAR; PG8_MMA(0, 0, At, B0); PG8_MMA(0, 1, At, B1); PG8_BAR; PG8_SCHED;
            PG8_LDA(At, 1, 1); PG8_STAGE(PG8_SB(1, 0), b3, voffB); PG8_STAGE(PG8_SB(1, 1), b3 + hstep, voffB); PG8_STAGE_A(PG8_SA(1, 0), 0, a3, g2);
            PG8_WAIT_V(8); PG8_WAIT_L(0); PG8_BAR; PG8_MMA(1, 0, At, B0); PG8_MMA(1, 1, At, B1); PG8_BAR; PG8_SCHED;
        }
        if (wr == 0) PG8_BAR;
        E(acc, cur, wr, wc, fr, fq);
        if (!has_next) break;
#pragma unroll
        for (int a = 0; a < 2; ++a)
#pragma unroll
            for (int b = 0; b < 2; ++b)
#pragma unroll
                for (int m = 0; m < 4; ++m)
#pragma unroll
                    for (int n = 0; n < 2; ++n) acc[a][b][m][n] = (f32x4){0.f, 0.f, 0.f, 0.f};
        cur = nxt; cA = nA; cB = nB; ++ui;
#pragma unroll
        for (int h = 0; h < 2; ++h)
#pragma unroll
            for (int i = 0; i < 2; ++i) gcur[h][i] = gnxt[h][i];
        if (wr == 1) PG8_BAR;
    }
    PG8_WAIT_V(0);
    PG8_BAR;
#undef PG8_SA
#undef PG8_SB
#undef PG8_STAGE
#undef PG8_STAGE_A
#undef PG8_LDA
#undef PG8_LDB
#undef PG8_MMA
#undef PG8_WAIT_V
#undef PG8_WAIT_L
#undef PG8_BAR
#undef PG8_SCHED
}
}

struct Args { const float* in[31]; float* out; unsigned char* ws; int ph_lo, ph_hi; };
enum { I_X = 0, I_C, I_ADAW, I_ADAB, I_NMIXG, I_NFFNG, I_ABWIN, I_SGULNG, I_SGULNB, I_SGUW, I_SGUB, I_POOLW, I_POOLSC, I_ABWOUT, I_CDWIN, I_C3W, I_C3B, I_C31W, I_C31B, I_CDLNG, I_CDLNB, I_CDWOUT,
       I_RW, I_RB, I_EW1, I_EW3, I_EW2, I_SW1, I_SW3, I_SW2, I_FG };

__device__ __forceinline__ void ph_mod_partial(const float* c, const float* ada_w, float* modp, LAS unsigned char* lds, int blk, int nblk) {
    const int tid = threadIdx.x, wave = __builtin_amdgcn_readfirstlane(tid >> 6), lane = tid & 63;
    LAS float* red = (LAS float*)lds;
    for (int task = blk; task < 384; task += nblk) {
        const int l = task / 192, rem = task % 192, nb = rem >> 2, kq = rem & 3;
        const int k0 = kq * 512 + wave * 64;
        int cv[16];
#pragma unroll
        for (int b = 0; b < 16; ++b) { const float x = c[b * DM + k0 + lane]; cv[b] = __builtin_bit_cast(int, x / (1.0f + __expf(-x))); }
        f32x4 acc[16];
#pragma unroll
        for (int b = 0; b < 16; ++b) acc[b] = (f32x4){0.f, 0.f, 0.f, 0.f};
        const float* wp = ada_w + ((size_t)l * DM + k0) * (6 * DM) + nb * 256 + lane * 4;
#pragma unroll 4
        for (int kk = 0; kk < 64; ++kk) {
            const f32x4 w = *(const f32x4*)(wp + (size_t)kk * (6 * DM));
#pragma unroll
            for (int b = 0; b < 16; ++b) { const float s = __builtin_bit_cast(float, __builtin_amdgcn_readlane(cv[b], kk)); acc[b] += w * s; }
        }
#pragma unroll
        for (int b = 0; b < 16; ++b) *(LAS f32x4*)(red + (wave * 16 + b) * 256 + lane * 4) = acc[b];
        __syncthreads();
#pragma unroll
        for (int j = 0; j < 2; ++j) { const int b = (tid >> 6) + 8 * j, c4 = tid & 63;
            f32x4 s = (f32x4){0.f, 0.f, 0.f, 0.f};
#pragma unroll
            for (int w = 0; w < 8; ++w) s += *(const LAS f32x4*)(red + (w * 16 + b) * 256 + c4 * 4);
            *(f32x4*)(modp + ((size_t)((kq * 2 + l) * 16 + b)) * (6 * DM) + nb * 256 + c4 * 4) = s; }
        __syncthreads();
    }
}
__device__ __forceinline__ void ph_mod_final(const float* modp, const float* ada_b, float* modf, int gtid, int ngt) {
    for (int i = gtid; i < 2 * 6 * 16 * DM; i += ngt) {
        const int d = i & (DM - 1), b = (i >> 11) & 15, j = (i >> 15) % 6, l = i / (6 * 16 * DM);
        const size_t src = ((size_t)(l * 16 + b)) * (6 * DM) + j * DM + d;
        float s = ada_b[l * 6 * DM + j * DM + d];
#pragma unroll
        for (int kq = 0; kq < 4; ++kq) s += modp[(size_t)kq * (2 * 16 * 6 * DM) + src];
        if (j == 1 || j == 4) s += 1.0f;
        modf[i] = s;
    }
}
__device__ __forceinline__ void conv_item(const float* W, int N, int k0, int n0, bf16_t* dst, int ldd, LAS float* scr, int lane) {
#pragma unroll 8
    for (int i = 0; i < 32; ++i) { const int kk = 2 * i + (lane >> 5); scr[kk * 33 + (lane & 31)] = W[(size_t)(k0 + kk) * N + n0 + (lane & 31)]; }
    LDS_WAIT(); asm volatile("" ::: "memory");
    const int c = lane & 7;
#pragma unroll
    for (int j = 0; j < 4; ++j) { const int n = (lane >> 3) + 8 * j; const LAS float* s = scr + (8 * c) * 33 + n;
        u32x4 o; o.x = cvt_pk_bf16(s[0 * 33], s[1 * 33]); o.y = cvt_pk_bf16(s[2 * 33], s[3 * 33]); o.z = cvt_pk_bf16(s[4 * 33], s[5 * 33]); o.w = cvt_pk_bf16(s[6 * 33], s[7 * 33]);
        *(u32x4*)(dst + (size_t)n * ldd + k0 + 8 * c) = o; }
    LDS_WAIT(); asm volatile("" ::: "memory");
}
__device__ __forceinline__ void conv_plain(const float* W, int K, int N, bf16_t* WT, int item, LAS float* scr, int lane) {
    const int nblk = N / 32, kb = item / nblk, nb = item % nblk;
    conv_item(W, N, 64 * kb, 32 * nb, WT + (size_t)(32 * nb) * K, K, scr, lane);
}
__device__ __forceinline__ void conv_gated(const float* W, int K, int N, bf16_t* WT, int half, int item, LAS float* scr, int lane) {
    const int nblk = N / 32, kb = item / nblk, nb = item % nblk, n0 = 32 * nb;
    conv_item(W, N, 64 * kb, n0, WT + (size_t)((n0 >> 7) * 256 + half * 128 + (n0 & 127)) * K, K, scr, lane);
}
__device__ __forceinline__ void conv_experts(const float* w1, const float* w3, const float* w2, int l, bf16_t* WE13, bf16_t* WE2, LAS float* scr, int gw, int ngw, int lane) {
    constexpr int I13 = (DM / 64) * (EFF / 32), I2 = (EFF / 64) * (DM / 32);
    constexpr int PER_E = 2 * I13 + I2;
    for (int it = gw; it < NE * PER_E; it += ngw) {
        const int e = it / PER_E; int r = it % PER_E;
        const size_t eo = (size_t)(l * NE + e) * DM * EFF;
        if (r < I13) { conv_gated(w1 + eo, DM, EFF, WE13 + (size_t)e * 768 * DM, 0, r, scr, lane); continue; } r -= I13;
        if (r < I13) { conv_gated(w3 + eo, DM, EFF, WE13 + (size_t)e * 768 * DM, 1, r, scr, lane); continue; } r -= I13;
        conv_plain(w2 + eo, EFF, DM, WE2 + (size_t)e * DM * EFF, r, scr, lane);
    }
}
__device__ __forceinline__ void ph_convert_misc(const Args& a, unsigned char* ws, LAS float* scr, int gw, int ngw, int lane, int gtid, int ngt) {
    constexpr int I_ABIN = 32 * 96, I_SQ = 32 * 64, I_CDIN = 32 * 160, I_SH = 32 * 16, I_RT = 32 * 2, I_SH2 = 8 * 64, I_PL = 4 * 8;
    constexpr int TOT = I_ABIN + I_SQ + I_CDIN + I_SQ + 2 * (2 * I_SH + I_RT + I_SH2) + 4 * I_PL;
    for (int it = gw; it < TOT; it += ngw) {
        int r = it;
        if (r < I_ABIN) { conv_plain(a.in[I_ABWIN], DM, 3072, (bf16_t*)(ws + WS_WABIN), r, scr, lane); continue; } r -= I_ABIN;
        if (r < I_SQ) { conv_plain(a.in[I_ABWOUT], DM, DM, (bf16_t*)(ws + WS_WABOUT), r, scr, lane); continue; } r -= I_SQ;
        if (r < I_CDIN) { conv_plain(a.in[I_CDWIN], DM, 5120, (bf16_t*)(ws + WS_WCDIN), r, scr, lane); continue; } r -= I_CDIN;
        if (r < I_SQ) { conv_plain(a.in[I_CDWOUT], DM, DM, (bf16_t*)(ws + WS_WCDOUT), r, scr, lane); continue; } r -= I_SQ;
        bool done = false;
#pragma unroll
        for (int l = 0; l < 2; ++l) {
            if (done) break;
            bf16_t* sh1 = (bf16_t*)(ws + WS_WSH1) + (size_t)l * 1280 * DM; bf16_t* sh2 = (bf16_t*)(ws + WS_WSH2) + (size_t)l * DM * SFF;
            if (r < I_SH) { conv_gated(a.in[I_SW1] + (size_t)l * DM * SFF, DM, SFF, sh1, 0, r, scr, lane); done = true; break; } r -= I_SH;
            if (r < I_SH) { conv_gated(a.in[I_SW3] + (size_t)l * DM * SFF, DM, SFF, sh1, 1, r, scr, lane); done = true; break; } r -= I_SH;
            if (r < I_RT) { conv_plain(a.in[I_RW] + (size_t)l * DM * NE, DM, NE, sh1 + (size_t)1024 * DM, r, scr, lane); done = true; break; } r -= I_RT;
            if (r < I_SH2) { conv_plain(a.in[I_SW2] + (size_t)l * SFF * DM, SFF, DM, sh2, r, scr, lane); done = true; break; } r -= I_SH2;
        }
        if (done) continue;
        { const int g = r / I_PL; conv_plain(a.in[I_POOLW] + (size_t)g * 65536, 256, 256, (bf16_t*)(ws + WS_WPOOL) + (size_t)g * 65536, r % I_PL, scr, lane); }
    }
    for (int i = gtid; i < 2 * 192 * DM / 8; i += ngt) { const int l = i / (192 * DM / 8), o = i % (192 * DM / 8);
        *(u32x4*)((bf16_t*)(ws + WS_WSH1) + (size_t)l * 1280 * DM + (size_t)1088 * DM + (size_t)o * 8) = (u32x4){0u, 0u, 0u, 0u}; }
    for (int i = gtid; i < 8 * 128 * 128 / 2; i += ngt) { const int e0 = i * 2, ii = (e0 >> 7) & 127, jj = e0 & 127; const bool ok = (ii >> 6) >= (jj >> 6);
        const f32x2 v = *(const f32x2*)(a.in[I_SGUW] + e0); ((unsigned*)(ws + WS_WSGU))[i] = ok ? cvt_pk_bf16(v.x, v.y) : 0u; }
}
__device__ __forceinline__ void ph_norm(const float* x, const float* g, const float* sc1p, const float* sh, bf16_t* h, int gw, int ngw, int lane) {
    for (int row = gw; row < NTOK; row += ngw) {
        const int b = row >> 11;
        const f32x4* xr = (const f32x4*)(x + (size_t)row * DM) + lane;
        f32x4 v[8]; float ss = 0.f;
#pragma unroll
        for (int j = 0; j < 8; ++j) { v[j] = xr[64 * j]; ss += (v[j][0] * v[j][0] + v[j][1] * v[j][1]) + (v[j][2] * v[j][2] + v[j][3] * v[j][3]); }
        const float rstd = __builtin_amdgcn_rsqf(wave_sum(ss) * (1.0f / DM) + EPS);
        const f32x4* g4 = (const f32x4*)g + lane; const f32x4* s4 = (const f32x4*)(sc1p + (size_t)b * DM) + lane; const f32x4* h4 = (const f32x4*)(sh + (size_t)b * DM) + lane;
        u32x2* o = (u32x2*)(h + (size_t)row * DM) + lane;
#pragma unroll
        for (int j = 0; j < 8; ++j) { const f32x4 r = v[j] * rstd * g4[64 * j] * s4[64 * j] + h4[64 * j];
            u32x2 w; w.x = cvt_pk_bf16(r[0], r[1]); w.y = cvt_pk_bf16(r[2], r[3]); o[64 * j] = w; }
    }
}
__device__ __forceinline__ void ph_final_norm(float* x, const float* g, int gw, int ngw, int lane) {
    for (int row = gw; row < NTOK; row += ngw) {
        f32x4* xr = (f32x4*)(x + (size_t)row * DM) + lane;
        f32x4 v[8]; float ss = 0.f;
#pragma unroll
        for (int j = 0; j < 8; ++j) { v[j] = xr[64 * j]; ss += (v[j][0] * v[j][0] + v[j][1] * v[j][1]) + (v[j][2] * v[j][2] + v[j][3] * v[j][3]); }
        const float rstd = __builtin_amdgcn_rsqf(wave_sum(ss) * (1.0f / DM) + EPS);
        const f32x4* g4 = (const f32x4*)g + lane;
#pragma unroll
        for (int j = 0; j < 8; ++j) xr[64 * j] = v[j] * rstd * g4[64 * j];
    }
}

constexpr int VP = 272;
constexpr int AP = 528;
constexpr int MX_V = 0, MX_A = 36864, MX_STAT = 36864 + 128 * AP;
__device__ __forceinline__ void ph_mixer_ab(const bf16_t* P, bf16_t* Y, const bf16_t* Wsgu, const float* sgu_b, const float* ln_g, const float* ln_b, const bf16_t* Wpool, const float* pool_scale,
                                            LAS unsigned char* lds, int blk, int nblk) {
    const int tid = threadIdx.x, w = __builtin_amdgcn_readfirstlane(tid >> 6), lane = tid & 63, fr = lane & 15, fq = lane >> 4;
    LAS f32x2* stat = (LAS f32x2*)(lds + MX_STAT);
    for (int unit = blk; unit < NTOK / 128; unit += nblk) {
        const int tok0 = unit * 128, pos0 = tok0 & (SEQ - 1);
        for (int i = 0; i < 16; ++i) { const int t = w * 16 + i; const u32x4* vr = (const u32x4*)(P + (size_t)(tok0 + t) * 3072 + 1024);
            float s = 0.f, q = 0.f;
#pragma unroll
            for (int j = 0; j < 2; ++j) { const u32x4 x = vr[lane + 64 * j];
#pragma unroll
                for (int e = 0; e < 4; ++e) { const float a = bf_lo(x[e]), b = bf_hi(x[e]); s += a + b; q += a * a + b * b; } }
            s = wave_sum(s); q = wave_sum(q);
            const float mean = s * (1.0f / 1024.0f), var = fmaxf(q * (1.0f / 1024.0f) - mean * mean, 0.f);
            if (lane == 0) stat[t] = (f32x2){mean, __builtin_amdgcn_rsqf(var + EPS)}; }
        __syncthreads();
        for (int h = 0; h < 8; ++h) {
#pragma unroll
            for (int j = 0; j < 4; ++j) { const int q = tid + 512 * j, t = q >> 4, c8 = q & 15;
                const u32x4 x = *(const u32x4*)(P + (size_t)(tok0 + t) * 3072 + 1024 + h * 128 + c8 * 8);
                const f32x2 st = stat[t];
                const f32x4 g0 = *(const f32x4*)(ln_g + h * 128 + c8 * 8), g1 = *(const f32x4*)(ln_g + h * 128 + c8 * 8 + 4);
                const f32x4 b0 = *(const f32x4*)(ln_b + h * 128 + c8 * 8), b1 = *(const f32x4*)(ln_b + h * 128 + c8 * 8 + 4);
                float r[8];
#pragma unroll
                for (int e = 0; e < 4; ++e) { r[2 * e] = bf_lo(x[e]); r[2 * e + 1] = bf_hi(x[e]); }
#pragma unroll
                for (int e = 0; e < 4; ++e) { r[e] = (r[e] - st.x) * st.y * g0[e] + b0[e]; r[4 + e] = (r[4 + e] - st.x) * st.y * g1[e] + b1[e]; }
                u32x4 o; o.x = cvt_pk_bf16(r[0], r[1]); o.y = cvt_pk_bf16(r[2], r[3]); o.z = cvt_pk_bf16(r[4], r[5]); o.w = cvt_pk_bf16(r[6], r[7]);
                *(LAS u32x4*)(lds + MX_V + t * VP + c8 * 16) = o; }
            __syncthreads();
            bf16x8 wsf[4];
#pragma unroll
            for (int ks = 0; ks < 4; ++ks) wsf[ks] = *(const bf16x8*)(Wsgu + ((size_t)(h * 128 + 16 * w + fr)) * 128 + 32 * ks + 8 * fq);
            f32x4 acc[8];
#pragma unroll
            for (int c = 0; c < 8; ++c) acc[c] = (f32x4){0.f, 0.f, 0.f, 0.f};
            const int q4 = fr >> 2, p4 = fr & 3;
#pragma unroll
            for (int c = 0; c < 8; ++c)
#pragma unroll
                for (int ks = 0; ks < 4; ++ks) {
                    const LAS unsigned char* a0 = lds + MX_V + (32 * ks + 8 * fq + q4) * VP + (16 * c + 4 * p4) * 2;
                    const bf16x4 lo = __builtin_amdgcn_ds_read_tr16_b64_v4i16((LAS bf16x4*)a0);
                    const bf16x4 hi = __builtin_amdgcn_ds_read_tr16_b64_v4i16((LAS bf16x4*)(a0 + 4 * VP));
                    const bf16x8 vf = __builtin_shufflevector(lo, hi, 0, 1, 2, 3, 4, 5, 6, 7);
                    acc[c] = __builtin_amdgcn_mfma_f32_16x16x32_bf16(vf, wsf[ks], acc[c], 0, 0, 0);
                }
            { const int t = 16 * w + fr; const float bias = sgu_b[h * 128 + t];
              const bf16_t* up = P + (size_t)(tok0 + t) * 3072 + h * 128 + 4 * fq; bf16_t* yp = Y + (size_t)(tok0 + t) * DM + h * 128 + 4 * fq;
#pragma unroll
              for (int c = 0; c < 8; ++c) { const u32x2 u = *(const u32x2*)(up + 16 * c);
                  u32x2 o; o.x = cvt_pk_bf16(bf_lo(u.x) * (acc[c][0] + bias), bf_hi(u.x) * (acc[c][1] + bias)); o.y = cvt_pk_bf16(bf_lo(u.y) * (acc[c][2] + bias), bf_hi(u.y) * (acc[c][3] + bias));
                  *(u32x2*)(yp + 16 * c) = o; } }
            __syncthreads();
        }
#pragma unroll
        for (int g = 0; g < 4; ++g) {
            const int win = 2 << g;
            { const int co = tid & 31, ts = tid >> 5, t0 = ts * 8, pos = pos0 + t0;
              const bf16_t* xp = P + (size_t)(tok0 + t0) * 3072 + 2048 + g * 256 + co * 8;
              float run[8];
#pragma unroll
              for (int e = 0; e < 8; ++e) run[e] = 0.f;
#pragma unroll
              for (int d = 1; d < win; ++d) if (pos - d >= 0) { const u32x4 x = *(const u32x4*)(xp - (size_t)d * 3072);
#pragma unroll
                  for (int e = 0; e < 4; ++e) { run[2 * e] += bf_lo(x[e]); run[2 * e + 1] += bf_hi(x[e]); } }
#pragma unroll
              for (int k = 0; k < 8; ++k) { const u32x4 x = *(const u32x4*)(xp + (size_t)k * 3072);
                  float xv[8];
#pragma unroll
                  for (int e = 0; e < 4; ++e) { xv[2 * e] = bf_lo(x[e]); xv[2 * e + 1] = bf_hi(x[e]); }
                  const int pk = pos + k; const float inv = 1.0f / (float)((pk + 1) < win ? (pk + 1) : win);
                  float r[8];
#pragma unroll
                  for (int e = 0; e < 8; ++e) { run[e] += xv[e]; r[e] = run[e] * inv - xv[e]; }
                  u32x4 o; o.x = cvt_pk_bf16(r[0], r[1]); o.y = cvt_pk_bf16(r[2], r[3]); o.z = cvt_pk_bf16(r[4], r[5]); o.w = cvt_pk_bf16(r[6], r[7]);
                  *(LAS u32x4*)(lds + MX_A + (t0 + k) * AP + co * 16) = o;
                  if (pk + 1 - win >= 0) { const u32x4 y = *(const u32x4*)(xp + ((long)k + 1 - win) * 3072);
#pragma unroll
                      for (int e = 0; e < 4; ++e) { run[2 * e] -= bf_lo(y[e]); run[2 * e + 1] -= bf_hi(y[e]); } } } }
            __syncthreads();
            f32x4 acc[2][8];
#pragma unroll
            for (int j = 0; j < 2; ++j)
#pragma unroll
                for (int tt = 0; tt < 8; ++tt) acc[j][tt] = (f32x4){0.f, 0.f, 0.f, 0.f};
#pragma unroll
            for (int ks = 0; ks < 8; ++ks) {
                bf16x8 wf[2];
#pragma unroll
                for (int j = 0; j < 2; ++j) wf[j] = *(const bf16x8*)(Wpool + ((size_t)(g * 256 + 32 * w + 16 * j + fr)) * 256 + 32 * ks + 8 * fq);
#pragma unroll
                for (int tt = 0; tt < 8; ++tt) { const bf16x8 pf = *(const LAS bf16x8*)(lds + MX_A + (16 * tt + fr) * AP + (32 * ks + 8 * fq) * 2);
#pragma unroll
                    for (int j = 0; j < 2; ++j) acc[j][tt] = __builtin_amdgcn_mfma_f32_16x16x32_bf16(wf[j], pf, acc[j][tt], 0, 0, 0); }
            }
#pragma unroll
            for (int j = 0; j < 2; ++j) { const int d = g * 256 + 32 * w + 16 * j + 4 * fq; const f32x4 sc = *(const f32x4*)(pool_scale + d);
#pragma unroll
                for (int tt = 0; tt < 8; ++tt) { const f32x4 v = acc[j][tt] * sc; u32x2 o; o.x = cvt_pk_bf16(v[0], v[1]); o.y = cvt_pk_bf16(v[2], v[3]);
                    *(u32x2*)(Y + (size_t)(tok0 + 16 * tt + fr) * DM + 1024 + d) = o; } }
            __syncthreads();
        }
    }
}

constexpr int CD_T = 32, CD_H = 30, CD_ROWS = CD_T + CD_H;
constexpr int CD_RED = (CD_ROWS + 1) * 2048, CD_STAT = MISC_OFF + 1024;
__device__ __forceinline__ void ph_mixer_cd(const bf16_t* P, bf16_t* Y, const float* c3w, const float* c3b, const float* c31w, const float* c31b, const float* ln_g, const float* ln_b,
                                            LAS unsigned char* lds, int blk, int nblk) {
    const int tid = threadIdx.x, w = __builtin_amdgcn_readfirstlane(tid >> 6), lane = tid & 63;
    LAS f32x2* red = (LAS f32x2*)(lds + CD_RED); LAS f32x2* stat = (LAS f32x2*)(lds + CD_STAT);
    const int c0 = 2 * tid;
    for (int unit = blk; unit < NTOK / CD_T; unit += nblk) {
        const int tok0 = unit * CD_T, pos0 = tok0 & (SEQ - 1);
        for (int q = tid; q < (CD_ROWS + 1) * 128; q += 512) { const int r = q >> 7, c8 = q & 127; const int pos = pos0 - CD_H + r;
            u32x4 o = (u32x4){0u, 0u, 0u, 0u};
            if (pos >= 0 && r < CD_ROWS) { const bf16_t* pp = P + (size_t)(tok0 - CD_H + r) * 5120 + 3072 + c8 * 8;
                const u32x4 a = *(const u32x4*)pp, g = *(const u32x4*)(pp + 1024);
#pragma unroll
                for (int e = 0; e < 4; ++e) o[e] = cvt_pk_bf16(bf_lo(a[e]) * fast_sigmoid(bf_lo(g[e])), bf_hi(a[e]) * fast_sigmoid(bf_hi(g[e]))); }
            *(LAS u32x4*)(lds + r * 2048 + c8 * 16) = o; }
        __syncthreads();
        f32x2 acc[CD_T];
        { const f32x2 bb = *(const f32x2*)(c31b + c0);
#pragma unroll
          for (int t = 0; t < CD_T; ++t) acc[t] = bb; }
#pragma unroll 1
        for (int kb = 0; kb < 8; ++kb) {
            f32x2 wk[4];
#pragma unroll
            for (int k = 0; k < 4; ++k) { const int kk = 4 * kb + k; wk[k] = (f32x2){0.f, 0.f}; if (kk < 31) wk[k] = *(const f32x2*)(c31w + kk * 1024 + c0); }
            f32x2 dv[CD_T + 3];
#pragma unroll
            for (int i = 0; i < CD_T + 3; ++i) { const unsigned d = *(const LAS unsigned*)(lds + (4 * kb + i) * 2048 + tid * 4); dv[i] = (f32x2){bf_lo(d), bf_hi(d)}; }
#pragma unroll
            for (int k = 0; k < 4; ++k)
#pragma unroll
                for (int t = 0; t < CD_T; ++t) acc[t] += wk[k] * dv[t + k];
        }
#pragma unroll
        for (int t = 0; t < CD_T; ++t) { const float s = wave_sum(acc[t].x + acc[t].y), q = wave_sum(acc[t].x * acc[t].x + acc[t].y * acc[t].y);
            if (lane == 0) red[w * CD_T + t] = (f32x2){s, q}; }
        __syncthreads();
        if (tid < CD_T) { float s = 0.f, q = 0.f;
#pragma unroll
            for (int ww = 0; ww < 8; ++ww) { const f32x2 v = red[ww * CD_T + tid]; s += v.x; q += v.y; }
            const float mean = s * (1.0f / 1024.0f), var = fmaxf(q * (1.0f / 1024.0f) - mean * mean, 0.f);
            stat[tid] = (f32x2){mean, __builtin_amdgcn_rsqf(var + EPS)}; }
        __syncthreads();
        { const f32x2 gg = *(const f32x2*)(ln_g + c0), bb = *(const f32x2*)(ln_b + c0);
#pragma unroll
          for (int t = 0; t < CD_T; ++t) { const f32x2 st = stat[t];
              const float a = (acc[t].x - st.x) * st.y * gg.x + bb.x, b = (acc[t].y - st.x) * st.y * gg.y + bb.y;
              *(unsigned*)(Y + (size_t)(tok0 + t) * DM + 1024 + c0) = cvt_pk_bf16(fast_silu(a), fast_silu(b)); } }
        { const f32x2 w0 = *(const f32x2*)(c3w + c0), w1 = *(const f32x2*)(c3w + 1024 + c0), w2 = *(const f32x2*)(c3w + 2048 + c0), bb = *(const f32x2*)(c3b + c0);
          f32x2 z0 = (f32x2){0.f, 0.f}, z1 = (f32x2){0.f, 0.f};
          if (pos0 >= 2) { const bf16_t* pp = P + (size_t)(tok0 - 2) * 5120 + c0; const unsigned cg = *(const unsigned*)(pp + 1024), xc = *(const unsigned*)(pp + 2048); z0 = (f32x2){bf_lo(cg) * bf_lo(xc), bf_hi(cg) * bf_hi(xc)}; }
          if (pos0 >= 1) { const bf16_t* pp = P + (size_t)(tok0 - 1) * 5120 + c0; const unsigned cg = *(const unsigned*)(pp + 1024), xc = *(const unsigned*)(pp + 2048); z1 = (f32x2){bf_lo(cg) * bf_lo(xc), bf_hi(cg) * bf_hi(xc)}; }
#pragma unroll 8
          for (int t = 0; t < CD_T; ++t) { const bf16_t* pp = P + (size_t)(tok0 + t) * 5120 + c0;
              const unsigned bg = *(const unsigned*)pp, cg = *(const unsigned*)(pp + 1024), xc = *(const unsigned*)(pp + 2048);
              const f32x2 z2 = (f32x2){bf_lo(cg) * bf_lo(xc), bf_hi(cg) * bf_hi(xc)};
              const f32x2 cv = bb + w0 * z0 + w1 * z1 + w2 * z2;
              *(unsigned*)(Y + (size_t)(tok0 + t) * DM + c0) = cvt_pk_bf16(bf_lo(bg) * cv.x, bf_hi(bg) * cv.y);
              z0 = z1; z1 = z2; } }
        __syncthreads();
    }
}

__device__ __forceinline__ void ph_route(const float* logits, const float* rbias, unsigned* gcnt, int* ts_e, int* ts_r, float* ts_w, LAS unsigned char* lds, int blk, int nblk) {
    const int tid = threadIdx.x, w = __builtin_amdgcn_readfirstlane(tid >> 6), lane = tid & 63;
    LAS unsigned* lcnt = (LAS unsigned*)lds; LAS unsigned* lbase = lcnt + 64; LAS unsigned* rec = lcnt + 128;
    const float rb = rbias[lane];
    for (int chunk = blk; chunk < NTOK / 128; chunk += nblk) {
        if (tid < 64) lcnt[tid] = 0u;
        __syncthreads();
        for (int i = 0; i < 16; ++i) { const int tl = w * 16 + i, tok = chunk * 128 + tl;
            const float score = 1.0f / (1.0f + __expf(-logits[(size_t)tok * NE + lane])), choice = score + rb;
            float m1 = choice, m2 = -INFINITY;
#pragma unroll
            for (int o = 1; o < 8; o <<= 1) { const float o1 = __shfl_xor(m1, o), o2 = __shfl_xor(m2, o); const float n1 = fmaxf(m1, o1), n2 = fmaxf(fminf(m1, o1), fmaxf(m2, o2)); m1 = n1; m2 = n2; }
            const float gs = m1 + m2; const int myg = lane >> 3; int grank = 0;
#pragma unroll
            for (int g = 0; g < 8; ++g) { const float s = __shfl(gs, g * 8); grank += (s > gs || (s == gs && g < myg)) ? 1 : 0; }
            const float masked = grank < 4 ? choice : -INFINITY;
            int rank = 0;
#pragma unroll 8
            for (int j = 0; j < 64; ++j) { const float v = __shfl(masked, j); rank += (v > masked || (v == masked && j < lane)) ? 1 : 0; }
            const bool sel = rank < TOPK;
            const float wsum = wave_sum(sel ? score : 0.f);
            if (sel) { const unsigned lp = atomicAdd((unsigned*)&lcnt[lane], 1u); rec[tl * TOPK + rank] = (unsigned)lane | (lp << 8); ts_w[(size_t)tok * TOPK + rank] = score / wsum * 2.5f; } }
        __syncthreads();
        if (tid < 64) lbase[tid] = atomicAdd(&gcnt[tid], lcnt[tid]);
        __syncthreads();
        for (int q = tid; q < 128 * TOPK; q += 512) { const unsigned r = rec[q]; const int e = r & 255; const size_t ts = (size_t)chunk * 128 * TOPK + q; ts_e[ts] = e; ts_r[ts] = (int)(lbase[e] + (r >> 8)); }
        __syncthreads();
    }
}
__device__ __forceinline__ void ph_build(unsigned* gcnt, unsigned* ntiles, const int* ts_e, const int* ts_r, const float* ts_w, int* rowtok, int* rowdst, float* roww, int* tile_e, LAS unsigned char* lds, int blk, int nblk) {
    const int tid = threadIdx.x;
    LAS int* cnt = (LAS int*)lds; LAS int* poff = cnt + 64;
    if (tid < 64) cnt[tid] = (int)__hip_atomic_load(gcnt + tid, __ATOMIC_RELAXED, __HIP_MEMORY_SCOPE_AGENT);
    __syncthreads();
    if (tid == 0) { int o = 0; for (int e = 0; e < 64; ++e) { poff[e] = o; o += (cnt[e] + 255) & ~255; } poff[64] = o; }
    __syncthreads();
    if (blk == 0 && tid == 0) __hip_atomic_store(ntiles, (unsigned)(poff[64] >> 8), __ATOMIC_RELAXED, __HIP_MEMORY_SCOPE_AGENT);
    for (size_t ts = (size_t)blk * 512 + tid; ts < (size_t)NSLOT; ts += (size_t)nblk * 512) { const int e = ts_e[ts], row = poff[e] + ts_r[ts]; rowtok[row] = (int)(ts / TOPK); rowdst[row] = (int)ts; roww[row] = ts_w[ts]; }
    for (int e = blk; e < 64; e += nblk) {
        const int p0 = poff[e], c = cnt[e], p1 = poff[e + 1];
        for (int r = p0 + c + tid; r < p1; r += 512) { rowtok[r] = 0; rowdst[r] = -1; roww[r] = 0.f; }
        for (int t = (p0 >> 8) + tid; t < (p1 >> 8); t += 512) tile_e[t] = e;
    }
}

constexpr int NPHASE = 25;
__host__ __device__ constexpr int phid(int k) { return k < 2 ? k : (k == 24 ? 13 : 2 + (k - 2) % 11); }
template <unsigned MASK> __global__ void __launch_bounds__(512, 2) mk_fwd(Args args) {
    extern __shared__ __attribute__((aligned(16))) unsigned char lds_raw[];
    LAS unsigned char* lds = (LAS unsigned char*)lds_raw;
    volatile LAS unsigned* MISC = (volatile LAS unsigned*)(lds + MISC_OFF);
    const int tid = threadIdx.x, lane = tid & 63, wave = __builtin_amdgcn_readfirstlane(tid >> 6);
    const int G = gridDim.x, blk = blockIdx.x;
    const int gw = blk * 8 + wave, ngw = G * 8, gtid = blk * 512 + tid, ngt = G * 512;
    unsigned char* ws = args.ws;
    unsigned* ctl = (unsigned*)(ws + WS_CTL);
    if (tid < 64) MISC[tid] = 0u;
    __syncthreads();
    XcdBarrier bar; bar.bar = ctl + CW_BAR; bar.x = 0; bar.st = nullptr;
    if (N_LAUNCH_MODE == 0) bar = xcd_barrier_post(ctl + CW_BAR, MISC + 8);
    const int lo = args.ph_lo, hi = args.ph_hi;
#define IN(k) (((MASK >> phid(k)) & 1u) != 0u && lo <= (k) && (k) < hi)
#define SEAM(k) do { if (N_LAUNCH_MODE == 0 && IN(k) && IN((k) + 1)) xcd_barrier(bar); } while (0)

    float* xres = args.out;
    float* modf = (float*)(ws + WS_MODF);
    bf16_t* Hb = (bf16_t*)(ws + WS_H); bf16_t* Pb = (bf16_t*)(ws + WS_P); bf16_t* Yb = (bf16_t*)(ws + WS_Y);
    bf16_t* SACT = (bf16_t*)(ws + WS_SACT); float* LOGIT = (float*)(ws + WS_LOGIT);
    bf16_t* ACT = (bf16_t*)(ws + WS_ACT); bf16_t* YBUF = (bf16_t*)(ws + WS_YBUF);
    bf16_t* WE13 = (bf16_t*)(ws + WS_WE13); bf16_t* WE2 = (bf16_t*)(ws + WS_WE2);
    int* ts_e = (int*)(ws + RT_TSE); int* ts_r = (int*)(ws + RT_TSR); float* ts_w = (float*)(ws + RT_TSW);
    int* rowtok = (int*)(ws + RT_ROWTOK); int* rowdst = (int*)(ws + RT_ROWDST); float* roww = (float*)(ws + RT_ROWW); int* tile_e = (int*)(ws + RT_TILEE);
    LAS float* scr = (LAS float*)(lds + wave * 16384);

    if (IN(0)) {
        ph_mod_partial(args.in[I_C], args.in[I_ADAW], (float*)(ws + WS_MODP), lds, blk, G);
        ph_convert_misc(args, ws, scr, gw, ngw, lane, gtid, ngt);
        conv_experts(args.in[I_EW1], args.in[I_EW3], args.in[I_EW2], 0, WE13, WE2, scr, gw, ngw, lane);
    }
    SEAM(0);
    if (IN(1)) ph_mod_final((const float*)(ws + WS_MODP), args.in[I_ADAB], modf, gtid, ngt);
    SEAM(1);

    for (int l = 0; l < 2; ++l) {
        const int pb = 2 + 11 * l;
        const float* mf = modf + (size_t)l * 6 * NB * DM;
        if (IN(pb + 0)) {
            ph_norm(l == 0 ? args.in[I_X] : xres, args.in[I_NMIXG] + l * DM, mf + 1 * NB * DM, mf + 0 * NB * DM, Hb, gw, ngw, lane);
            if (l == 1) conv_experts(args.in[I_EW1], args.in[I_EW3], args.in[I_EW2], 1, WE13, WE2, scr, gw, ngw, lane);
        }
        SEAM(pb + 0);
        if (IN(pb + 1)) {
            const int N = l == 0 ? 3072 : 5120;
            pg8::StaticOrder S; S.init(Hb, (const bf16_t*)(ws + (l == 0 ? WS_WABIN : WS_WCDIN)), DM, NTOK, N, G, blk);
            pg8::EpiBf16 E{Pb, N};
            pg8::gemm_phase<pg8::EpiBf16, pg8::StaticOrder, DM, false>(lds, S, E);
        }
        SEAM(pb + 1);
        if (IN(pb + 2)) {
            if (l == 0) ph_mixer_ab(Pb, Yb, (const bf16_t*)(ws + WS_WSGU), args.in[I_SGUB], args.in[I_SGULNG], args.in[I_SGULNB], (const bf16_t*)(ws + WS_WPOOL), args.in[I_POOLSC], lds, blk, G);
            else ph_mixer_cd(Pb, Yb, args.in[I_C3W], args.in[I_C3B], args.in[I_C31W], args.in[I_C31B], args.in[I_CDLNG], args.in[I_CDLNB], lds, blk, G);
        }
        SEAM(pb + 2);
        if (IN(pb + 3)) {
            pg8::StaticOrder S; S.init(Yb, (const bf16_t*)(ws + (l == 0 ? WS_WABOUT : WS_WCDOUT)), DM, NTOK, DM, G, blk);
            pg8::EpiResGate E{l == 0 ? args.in[I_X] : xres, xres, mf + 2 * NB * DM};
            pg8::gemm_phase<pg8::EpiResGate, pg8::StaticOrder, DM, false>(lds, S, E);
        }
        SEAM(pb + 3);
        if (IN(pb + 4)) ph_norm(xres, args.in[I_NFFNG] + l * DM, mf + 4 * NB * DM, mf + 3 * NB * DM, Hb, gw, ngw, lane);
        SEAM(pb + 4);
        if (IN(pb + 5)) {
            pg8::StaticOrder S; S.init(Hb, (const bf16_t*)(ws + WS_WSH1) + (size_t)l * 1280 * DM, DM, NTOK, 1280, G, blk);
            pg8::EpiSiluMul E{SACT, SFF, LOGIT, 4};
            pg8::gemm_phase<pg8::EpiSiluMul, pg8::StaticOrder, DM, false>(lds, S, E);
        }
        SEAM(pb + 5);
        if (IN(pb + 6)) ph_route(LOGIT, args.in[I_RB] + l * NE, ctl + CW_GCNT + l * 64, ts_e, ts_r, ts_w, lds, blk, G);
        SEAM(pb + 6);
        if (IN(pb + 7)) ph_build(ctl + CW_GCNT + l * 64, ctl + CW_NTILES + l, ts_e, ts_r, ts_w, rowtok, rowdst, roww, tile_e, lds, blk, G);
        SEAM(pb + 7);
        if (IN(pb + 8)) {
            const int mt = (int)__builtin_amdgcn_readfirstlane(__hip_atomic_load(ctl + CW_NTILES + l, __ATOMIC_RELAXED, __HIP_MEMORY_SCOPE_AGENT));
            pg8::ExpertOrder S{(const char*)Hb, (const char*)WE13, tile_e, rowtok, (size_t)256 * DM * 2, (size_t)768 * DM * 2, 3, mt * 3, G, blk, true};
            pg8::EpiSiluMul E{ACT, EFF, nullptr, -1};
            pg8::gemm_phase<pg8::EpiSiluMul, pg8::ExpertOrder, DM, true>(lds, S, E);
        }
        SEAM(pb + 8);
        if (IN(pb + 9)) {
            const int mt = (int)__builtin_amdgcn_readfirstlane(__hip_atomic_load(ctl + CW_NTILES + l, __ATOMIC_RELAXED, __HIP_MEMORY_SCOPE_AGENT));
            pg8::ExpertOrder S{(const char*)ACT, (const char*)WE2, tile_e, rowtok, (size_t)256 * EFF * 2, (size_t)DM * EFF * 2, 8, mt * 8, G, blk, false};
            pg8::EpiScatterY E{YBUF, rowdst, roww};
            pg8::gemm_phase<pg8::EpiScatterY, pg8::ExpertOrder, EFF, false>(lds, S, E);
        }
        SEAM(pb + 9);
        if (IN(pb + 10)) {
            pg8::StaticOrder S; S.init(SACT, (const bf16_t*)(ws + WS_WSH2) + (size_t)l * DM * SFF, SFF, NTOK, DM, G, blk);
            pg8::EpiCombine E{xres, xres, mf + 5 * NB * DM, YBUF};
            pg8::gemm_phase<pg8::EpiCombine, pg8::StaticOrder, SFF, false>(lds, S, E);
        }
        SEAM(pb + 10);
    }
    if (IN(24)) ph_final_norm(xres, args.in[I_FG], gw, ngw, lane);
#undef IN
#undef SEAM
}

typedef void (*KernFn)(Args);
#if N_LAUNCH_MODE == 0
static KernFn kern_of(int) { return mk_fwd<0x3FFFu>; }
constexpr int NKERN = 1;
#else
static KernFn kern_of(int id) {
    switch (id) {
        case 0: return mk_fwd<1u << 0>; case 1: return mk_fwd<1u << 1>; case 2: return mk_fwd<1u << 2>; case 3: return mk_fwd<1u << 3>; case 4: return mk_fwd<1u << 4>;
        case 5: return mk_fwd<1u << 5>; case 6: return mk_fwd<1u << 6>; case 7: return mk_fwd<1u << 7>; case 8: return mk_fwd<1u << 8>; case 9: return mk_fwd<1u << 9>;
        case 10: return mk_fwd<1u << 10>; case 11: return mk_fwd<1u << 11>; case 12: return mk_fwd<1u << 12>; default: return mk_fwd<1u << 13>;
    }
}
constexpr int NKERN = 14;
#endif
extern "C" void kernel_launch(void* const* d_in, const int* in_sizes, int n_in, void* d_out, int out_size, void* d_ws, size_t ws_size, hipStream_t stream) {
    static int grid = 0;
    if (grid == 0) {
        if (n_in != 31 || out_size != NTOK * DM || ws_size < WS_END) { fprintf(stderr, "kernel_launch: unexpected shapes/workspace (n_in %d, out %d, ws %zu < %zu)\n", n_in, out_size, ws_size, (size_t)WS_END); grid = -1; return; }
        int dev = 0, cus = 0, per_cu = 0;
        if (hipGetDevice(&dev) != hipSuccess || hipDeviceGetAttribute(&cus, hipDeviceAttributeMultiprocessorCount, dev) != hipSuccess) { grid = -1; return; }
        for (int i = 0; i < NKERN; ++i)
            if (hipFuncSetAttribute((const void*)kern_of(i), hipFuncAttributeMaxDynamicSharedMemorySize, LDS_BYTES) != hipSuccess) { fprintf(stderr, "kernel_launch: hipFuncSetAttribute failed\n"); grid = -1; return; }
        if (hipOccupancyMaxActiveBlocksPerMultiprocessor(&per_cu, (const void*)kern_of(0), 512, LDS_BYTES) != hipSuccess || per_cu < 1) fprintf(stderr, "kernel_launch: occupancy query says %d\n", per_cu);
        (void)hipGetLastError();
        grid = cus;
    }
    if (grid < 0) return;
    (void)hipMemsetAsync((char*)d_ws + WS_CTL, 0, CTL_BYTES, stream);
    Args a{};
    for (int i = 0; i < 31; ++i) a.in[i] = (const float*)d_in[i];
    a.out = (float*)d_out; a.ws = (unsigned char*)d_ws;
    if (N_LAUNCH_MODE == 0) {
        a.ph_lo = 0; a.ph_hi = NPHASE;
        hipLaunchKernelGGL(kern_of(0), dim3(grid), dim3(512), LDS_BYTES, stream, a);
    } else {
        for (int p = 0; p < NPHASE; ++p) { a.ph_lo = p; a.ph_hi = p + 1; hipLaunchKernelGGL(kern_of(phid(p)), dim3(grid), dim3(512), LDS_BYTES, stream, a); }
    }
}
```

```cpp
#include <hip/hip_runtime.h>
#include <cstdio>
#include <cstdint>

#ifndef REP_MASK
#define REP_MASK 0u
#endif
#ifndef PROBE_N
#define PROBE_N 0
#define PROBE_LIST {0}
#define PROBE_FLAG {1}
#endif
#ifndef N_LAUNCH_MODE
#define N_LAUNCH_MODE 0
#endif

#define LAS __attribute__((address_space(3)))
typedef unsigned short bf16_t;
typedef short bf16x8 __attribute__((ext_vector_type(8)));
typedef short bf16x4 __attribute__((ext_vector_type(4)));
typedef float f32x4 __attribute__((ext_vector_type(4)));
typedef float f32x2 __attribute__((ext_vector_type(2)));
typedef unsigned u32x4 __attribute__((ext_vector_type(4)));
typedef unsigned u32x2 __attribute__((ext_vector_type(2)));
typedef int i32x4 __attribute__((ext_vector_type(4)));

constexpr int DM = 2048, NB = 16, SEQ = 2048, NTOK = NB * SEQ;
constexpr int NE = 64, TOPK = 6, EFF = 384, SFF = 512;
constexpr int NSLOT = NTOK * TOPK;
constexpr int ECAP = NTOK;
constexpr int MAXROWS = NE * ECAP;
constexpr int MAXTILES = NSLOT / 256 + NE;
constexpr float EPS = 1e-6f;

constexpr size_t MiB = 1u << 20;
constexpr size_t WS_CTL = 0, CTL_BYTES = 1 * MiB;
constexpr size_t WS_MODP = 1 * MiB;
constexpr size_t WS_MODF = 7 * MiB;
constexpr int HP = 2112;
constexpr size_t WS_WSH1 = 57 * MiB;
constexpr size_t WS_WSH2 = 67 * MiB;
constexpr size_t WS_WSGU = 71 * MiB;
constexpr size_t WS_WPOOL = 71 * MiB + 512 * 1024;
constexpr size_t WS_WE13 = 72 * MiB;
constexpr size_t WS_WE2 = 264 * MiB;
constexpr size_t WS_H = 360 * MiB;
constexpr size_t WS_WRS = WS_H, WS_CBP = WS_H + 8 * MiB;
constexpr size_t WS_WE2B = WS_H + 16 * MiB;
constexpr size_t WS_SACT = 492 * MiB;
constexpr size_t WS_WSH1F8 = 520 * MiB;
constexpr size_t WS_WSH2F8 = 524 * MiB;
constexpr size_t WS_ROUTE = 528 * MiB;
constexpr size_t WS_R = 534 * MiB;
constexpr size_t WS_P = WS_R, WS_Y = WS_R + 320 * MiB;
constexpr size_t WS_ACT = WS_R, WS_YBUF = WS_R + 256 * MiB;
constexpr size_t WS_XB = WS_R + 704 * MiB;
constexpr size_t WS_H8 = WS_R + 640 * MiB;
constexpr size_t WS_SHOUT = WS_R + 924 * MiB;
constexpr size_t WS_WABIN = WS_SHOUT + 128 * MiB;
constexpr size_t WS_WABOUT = WS_WABIN + 13 * MiB;
constexpr size_t WS_WCDIN = WS_WABOUT + 9 * MiB;
constexpr size_t WS_WCDOUT = WS_WCDIN + 21 * MiB;
constexpr size_t WS_LISTS = WS_WCDOUT + 9 * MiB;
constexpr size_t WS_END = WS_LISTS + 24 * MiB;
constexpr size_t RT_ROWTOK = WS_LISTS, RT_ROWDST = RT_ROWTOK + (size_t)MAXROWS * 4, RT_ROWW = RT_ROWDST + (size_t)MAXROWS * 4;
static_assert(RT_ROWW + (size_t)MAXROWS * 4 <= WS_END, "route map");
constexpr int CW_BAR = 4096;
constexpr int CW_GCNT = 16384;
constexpr int CW_NTILES = 16384 + 256;

constexpr int RING_BYTES = 131072;
constexpr int MISC_OFF = RING_BYTES;
constexpr int SIDE_TILEE = 131072 + 4096;
constexpr int SIDE_ROWS = 131072 + 8192;
constexpr int LDS_BYTES = 147456;

__device__ __forceinline__ unsigned cvt_pk_bf16(float lo, float hi) { unsigned r; asm volatile("v_cvt_pk_bf16_f32 %0, %1, %2" : "=v"(r) : "v"(lo), "v"(hi)); return r; }
__device__ __forceinline__ float bf_lo(unsigned w) { return __builtin_bit_cast(float, w << 16); }
__device__ __forceinline__ float bf_hi(unsigned w) { return __builtin_bit_cast(float, w & 0xffff0000u); }
__device__ __forceinline__ float fast_sigmoid(float x) { return __builtin_amdgcn_rcpf(1.0f + __builtin_amdgcn_exp2f(-1.44269504f * x)); }
__device__ __forceinline__ float fast_silu(float x) { return x * fast_sigmoid(x); }
__device__ __forceinline__ float shfl_xor_l(float v, int o, int lane) { return __builtin_bit_cast(float, __builtin_amdgcn_ds_bpermute((lane ^ o) << 2, __builtin_bit_cast(int, v))); }
__device__ __forceinline__ float rdlane(float v, int j) { return __builtin_bit_cast(float, __builtin_amdgcn_readlane(__builtin_bit_cast(int, v), j)); }
template <int CTRL, int ROWM = 0xf> __device__ __forceinline__ float dpp_f(float old, float src) {
    return __builtin_bit_cast(float, __builtin_amdgcn_update_dpp(__builtin_bit_cast(int, old), __builtin_bit_cast(int, src), CTRL, ROWM, 0xf, false)); }
__device__ __forceinline__ float wave_sum(float v, int) {
    v += dpp_f<0x111>(0.f, v); v += dpp_f<0x112>(0.f, v); v += dpp_f<0x114>(0.f, v); v += dpp_f<0x118>(0.f, v);
    v += dpp_f<0x142, 0xa>(0.f, v);
    v += dpp_f<0x143, 0xc>(0.f, v);
    return rdlane(v, 63);
}
__device__ __forceinline__ float wave_max(float v) {
    v = fmaxf(v, dpp_f<0x111>(v, v)); v = fmaxf(v, dpp_f<0x112>(v, v)); v = fmaxf(v, dpp_f<0x114>(v, v)); v = fmaxf(v, dpp_f<0x118>(v, v));
    v = fmaxf(v, dpp_f<0x142, 0xa>(v, v));
    v = fmaxf(v, dpp_f<0x143, 0xc>(v, v));
    return rdlane(v, 63);
}
#define LDS_WAIT() asm volatile("s_waitcnt lgkmcnt(0)" ::: "memory")
#define VM_WAIT() asm volatile("s_waitcnt vmcnt(0)" ::: "memory")

#define XB_TMO      128
#define XB_XCNT(j)  (256  + 64 * (j))
#define XB_XSUB(j)  (1280 + 64 * (j))
#define XB_XGEN(j)  (2304 + 64 * (j))
#define XB_TOP      3328
#define XB_TOPGEN   3392
#define XCD_BAR_WORDS 3456
#define XB_SPIN_CAP (1u << 20)
__device__ __forceinline__ unsigned xb_ld(unsigned* p)              { return __hip_atomic_load(p, __ATOMIC_RELAXED, __HIP_MEMORY_SCOPE_AGENT); }
__device__ __forceinline__ unsigned xb_add(unsigned* p, unsigned v) { return __hip_atomic_fetch_add(p, v, __ATOMIC_RELAXED, __HIP_MEMORY_SCOPE_AGENT); }
__device__ __forceinline__ unsigned xb_xcc_id() { return (unsigned)__builtin_amdgcn_s_getreg((3 << 11) | 20) & 0xFu; }
#define XB_SPIN(cond, bar) do { unsigned _sp = 0; while (cond) { __builtin_amdgcn_s_sleep(1); \
    if ((++_sp & 255u) == 0u) { if (xb_ld(&(bar)[XB_TMO])) break; if (_sp > XB_SPIN_CAP) { atomicAdd(&(bar)[XB_TMO], 1u); break; } } } } while (0)
struct XcdBarrier { unsigned* bar; unsigned x; volatile LAS unsigned* st; };
__device__ __forceinline__ XcdBarrier xcd_barrier_post(unsigned* bar, volatile LAS unsigned* st, int tid) {
    XcdBarrier b; b.bar = bar; b.x = xb_xcc_id(); b.st = st;
    if (tid == 0) (void)xb_add(&bar[XB_XCNT(b.x)], 1u);
    return b;
}
__device__ __forceinline__ void xcd_barrier_complete(unsigned* bar, unsigned x, unsigned& nloc, unsigned& nx) {
    const unsigned G = gridDim.x * gridDim.y * gridDim.z;
    unsigned sum, cnt, mine, sp = 0u;
    for (;;) {
        sum = 0u; cnt = 0u; mine = 0u;
#pragma unroll
        for (unsigned j = 0; j < 16; ++j) { const unsigned c = xb_ld(&bar[XB_XCNT(j)]); sum += c; cnt += (c > 0u) ? 1u : 0u; mine = (j == x) ? c : mine; }
        if (sum == G) break;
        __builtin_amdgcn_s_sleep(1);
        if ((++sp & 255u) == 0u) { if (xb_ld(&bar[XB_TMO])) break; if (sp > XB_SPIN_CAP) { atomicAdd(&bar[XB_TMO], 1u); break; } }
    }
    nloc = mine > 0u ? mine : 1u; nx = cnt > 0u ? cnt : 1u;
}
__device__ __forceinline__ void xcd_barrier(const XcdBarrier& b, int tid) {
    asm volatile("s_waitcnt vmcnt(0)" ::: "memory");
    __syncthreads();
    if (tid == 0) {
        unsigned* bar = b.bar; unsigned bx = b.x; asm volatile("" : "+s"(bar), "+s"(bx));
        __builtin_amdgcn_s_waitcnt(0);
        unsigned nloc = b.st[0], nx = b.st[1];
        if (nloc == 0u) { xcd_barrier_complete(bar, bx, nloc, nx); b.st[0] = nloc; b.st[1] = nx; }
        const unsigned old = xb_add(&bar[XB_XSUB(bx)], 1u);
        const unsigned gen = old / nloc;
        if (old + 1u == (gen + 1u) * nloc) {
            __builtin_amdgcn_fence(__ATOMIC_RELEASE, "agent");
            asm volatile("s_waitcnt vmcnt(0)" ::: "memory");
            const unsigned og = xb_add(&bar[XB_TOP], 1u);
            const unsigned tg = og / nx;
            if (og + 1u == (tg + 1u) * nx) xb_add(&bar[XB_TOPGEN], 1u);
            else XB_SPIN(xb_ld(&bar[XB_TOPGEN]) == tg, bar);
            __builtin_amdgcn_fence(__ATOMIC_ACQUIRE, "agent");
            xb_add(&bar[XB_XGEN(bx)], 1u);
            asm volatile("s_waitcnt vmcnt(0)" ::: "memory");
        } else {
            XB_SPIN(xb_ld(&bar[XB_XGEN(bx)]) == gen, bar);
            __builtin_amdgcn_fence(__ATOMIC_ACQUIRE, "agent");
            asm volatile("s_waitcnt vmcnt(0)" ::: "memory");
        }
    }
    __syncthreads();
}

namespace pg8 {
constexpr int BM = 256, BK = 64, HALF = 128, HTB = HALF * BK * 2, STAGE_BYTES = 8 * HTB, NXCD = 8, WGM = 8;
__host__ __device__ __forceinline__ int lds_byte(int r, int c) { const int st = (r >> 4) * 2 + (c >> 5), rr = r & 15, cc = c & 31, ob = rr * 64 + cc * 2; return st * 1024 + (ob ^ (((ob >> 9) & 1) << 5)); }
__host__ __device__ __forceinline__ void stage_rc(int b, int& R, int& C) { const int st = b / 1024, sb = b % 1024, swz = sb ^ (((sb >> 9) & 1) << 5); R = (st >> 1) * 16 + swz / 64; C = (st & 1) * 32 + (swz % 64) / 2; }
__host__ __device__ __forceinline__ int perm32(int rho) { const int n = rho >> 4, i = rho & 15; return 8 * (i >> 2) + 4 * n + (i & 3); }

struct Unit { int pm, pn, e, rb, nv; };

__device__ __forceinline__ int xcd_remap(int L, int nwg) { const int q = nwg / NXCD, r = nwg % NXCD, xcd = L % NXCD, off = L / NXCD; return (xcd < r ? xcd * (q + 1) : r * (q + 1) + (xcd - r) * q) + off; }

struct StaticOrder {
    static constexpr bool SIDE = false;
    const char* A; const char* Bt; size_t tstepA, tstepB; int nM, nN, nwg, G, c;
    __device__ void init(const void* A_, const void* Bt_, int K, int M, int N, int G_, int c_, int es = 2, int lda = 0, int ldb = 0) { A = (const char*)A_; Bt = (const char*)Bt_; tstepA = (size_t)BM * (lda ? lda : K * es); tstepB = (size_t)BM * (ldb ? ldb : K * es); nM = M / BM; nN = N / BM; nwg = nM * nN; G = G_; c = c_; }
    __device__ __forceinline__ bool next(int i, Unit& u) const {
        const int L = i * G + c; if (L >= nwg) return false;
        const int wgid = xcd_remap(L, nwg);
        const int nig = WGM * nN, gid = wgid / nig, fm = gid * WGM, gsz = (nM - fm) < WGM ? (nM - fm) : WGM;
        u.pm = fm + ((wgid % nig) % gsz); u.pn = (wgid % nig) / gsz; u.e = 0; u.rb = u.pm * BM; u.nv = BM; return true;
    }
    __device__ __forceinline__ const char* a_ptr(const Unit& u) const { return A + (size_t)u.pm * tstepA; }
    __device__ __forceinline__ const char* b_ptr(const Unit& u) const { return Bt + (size_t)u.pn * tstepB; }
    __device__ __forceinline__ const int* side_ptr(const Unit&, int) const { return nullptr; }
};
template <int TSTEP  , int BSTRIDE  , int NN  , bool GATHER_>
struct ExpertOrder {
    static constexpr bool SIDE = true;
    const char* A; const char* Bt; const LAS int* tile_lds; const int* side0; const int* side1; int nwg, G, c;
    __device__ __forceinline__ bool next(int i, Unit& u) const {
        const int L = i * G + c; if (L >= nwg) return false;
        const int wgid = xcd_remap(L, nwg);
        u.pm = wgid / NN; u.pn = wgid % NN;
        const int t = __builtin_amdgcn_readfirstlane(tile_lds[u.pm]);
        u.e = (int)((unsigned)t >> 26); u.rb = u.e * ECAP + ((t >> 16) & 127) * BM; u.nv = t & 0x1ff; return true;
    }
    __device__ __forceinline__ const char* a_ptr(const Unit& u) const { return GATHER_ ? A : A + (size_t)u.pm * TSTEP; }
    __device__ __forceinline__ const char* b_ptr(const Unit& u) const { return Bt + (size_t)u.e * BSTRIDE + (size_t)u.pn * TSTEP; }
    __device__ __forceinline__ const int* side_ptr(const Unit& u, int wid) const { return (wid < 4 ? side0 : side1) + (size_t)u.rb + (wid & 3) * 64; }
};
struct EpiBf16 {
    static constexpr int PERM = 1;
    bf16_t* O; int ldc; float scl;
    __device__ __forceinline__ int nst(const Unit&) const { return 16; }
    __device__ __forceinline__ void operator()(const f32x4 (&acc)[2][2][4][2], const Unit& u, int tid_in, const LAS unsigned char* side) const {
        int t_ = tid_in; asm volatile("" : "+v"(t_));
        const int wid_ = __builtin_amdgcn_readfirstlane(t_ >> 6), wr = wid_ >> 2, wc = wid_ & 3, fr = t_ & 15, fq = (t_ & 63) >> 4;
        const int row0 = u.pm * BM + wr * 64 + fr, col0 = u.pn * BM + wc * 32 + 8 * fq;
#pragma unroll
        for (int ai = 0; ai < 2; ++ai)
#pragma unroll
            for (int m = 0; m < 4; ++m) { bf16_t* rowp = O + (size_t)(row0 + ai * HALF + m * 16) * ldc + col0;
#pragma unroll
                for (int bj = 0; bj < 2; ++bj) { const f32x4 v0 = acc[ai][bj][m][0] * scl, v1 = acc[ai][bj][m][1] * scl;
                    u32x4 w; w.x = cvt_pk_bf16(v0[0], v0[1]); w.y = cvt_pk_bf16(v0[2], v0[3]); w.z = cvt_pk_bf16(v1[0], v1[1]); w.w = cvt_pk_bf16(v1[2], v1[3]);
                    *(u32x4*)(rowp + bj * HALF) = w; } }
    }
};
template <bool BASE_F32> struct EpiResGate {
    static constexpr int PERM = 1;
    const void* base; bf16_t* out; const float* gate; int mode; float scl;
    __device__ __forceinline__ int nst(const Unit&) const { return (PROBE_N > 0 && mode == 2) ? 0 : 8; }
    __device__ __forceinline__ void operator()(const f32x4 (&acc)[2][2][4][2], const Unit& u, int tid_in, const LAS unsigned char* side) const {
        if (PROBE_N > 0 && mode == 2) { if (acc[0][0][0][0][0] != 123.456f && acc[1][1][3][1][3] != 0.1234f) return; }
        int t_ = tid_in; asm volatile("" : "+v"(t_));
        const int wid_ = __builtin_amdgcn_readfirstlane(t_ >> 6), wr = wid_ >> 2, wc = wid_ & 3, fr = t_ & 15, fq = (t_ & 63) >> 4;
        const int row0 = u.pm * BM + wr * 64 + fr, col0 = u.pn * BM + wc * 32 + 8 * fq;
        const float* gp = gate + (size_t)(u.pm >> 3) * DM + col0;
        f32x4 gv[2][2];
#pragma unroll
        for (int bj = 0; bj < 2; ++bj)
#pragma unroll
            for (int n = 0; n < 2; ++n) gv[bj][n] = *(const f32x4*)(gp + bj * HALF + n * 4) * scl;
#pragma unroll
        for (int ai = 0; ai < 2; ++ai) {
            f32x4 b0[4][2], b1[4][2];
#pragma unroll
            for (int m = 0; m < 4; ++m) { const size_t off = (size_t)(row0 + ai * HALF + m * 16) * DM + col0;
#pragma unroll
                for (int bj = 0; bj < 2; ++bj) {
                    if constexpr (BASE_F32) { b0[m][bj] = *(const f32x4*)((const float*)base + off + bj * HALF); b1[m][bj] = *(const f32x4*)((const float*)base + off + bj * HALF + 4); }
                    else { const u32x4 t = *(const u32x4*)((const bf16_t*)base + off + bj * HALF); b0[m][bj] = (f32x4){bf_lo(t.x), bf_hi(t.x), bf_lo(t.y), bf_hi(t.y)}; b1[m][bj] = (f32x4){bf_lo(t.z), bf_hi(t.z), bf_lo(t.w), bf_hi(t.w)}; } } }
#pragma unroll
            for (int m = 0; m < 4; ++m) { const size_t off = (size_t)(row0 + ai * HALF + m * 16) * DM + col0;
#pragma unroll
                for (int bj = 0; bj < 2; ++bj) { const f32x4 v0 = b0[m][bj] + gv[bj][0] * acc[ai][bj][m][0], v1 = b1[m][bj] + gv[bj][1] * acc[ai][bj][m][1];
                    u32x4 w; w.x = cvt_pk_bf16(v0[0], v0[1]); w.y = cvt_pk_bf16(v0[2], v0[3]); w.z = cvt_pk_bf16(v1[0], v1[1]); w.w = cvt_pk_bf16(v1[2], v1[3]);
                    *(u32x4*)(out + off + bj * HALF) = w; } }
        }
    }
};
struct EpiCdIn {
    static constexpr int PERM = 1;
    bf16_t* O; float scl;
    __device__ __forceinline__ int nst(const Unit& u) const { return u.pn < 4 ? 16 : 8; }
    __device__ __forceinline__ void operator()(const f32x4 (&acc)[2][2][4][2], const Unit& u, int tid_in, const LAS unsigned char* side) const {
        int t_ = tid_in; asm volatile("" : "+v"(t_));
        const int wid_ = __builtin_amdgcn_readfirstlane(t_ >> 6), wr = wid_ >> 2, wc = wid_ & 3, fr = t_ & 15, fq = (t_ & 63) >> 4;
        const int row0 = u.pm * BM + wr * 64 + fr, oc = wc * 32 + 8 * fq;
        if (u.pn < 4) {
#pragma unroll
            for (int ai = 0; ai < 2; ++ai)
#pragma unroll
                for (int m = 0; m < 4; ++m) { bf16_t* rowp = O + (size_t)(row0 + ai * HALF + m * 16) * 3072 + u.pn * BM + oc;
#pragma unroll
                    for (int bj = 0; bj < 2; ++bj) { const f32x4 v0 = acc[ai][bj][m][0] * scl, v1 = acc[ai][bj][m][1] * scl;
                        u32x4 w; w.x = cvt_pk_bf16(v0[0], v0[1]); w.y = cvt_pk_bf16(v0[2], v0[3]); w.z = cvt_pk_bf16(v1[0], v1[1]); w.w = cvt_pk_bf16(v1[2], v1[3]);
                        *(u32x4*)(rowp + bj * HALF) = w; } }
            return;
        }
        const bool gate = u.pn >= 12; const int ocol = (gate ? 2048 + (u.pn - 12) * HALF : 1024 + (u.pn - 4) * HALF) + oc;
#pragma unroll
        for (int ai = 0; ai < 2; ++ai)
#pragma unroll
            for (int m = 0; m < 4; ++m) { float r[8];
#pragma unroll
                for (int n = 0; n < 2; ++n)
#pragma unroll
                    for (int j = 0; j < 4; ++j) { const float a = acc[ai][0][m][n][j] * scl, b = acc[ai][1][m][n][j] * scl; r[n * 4 + j] = a * (gate ? fast_sigmoid(b) : b); }
                u32x4 w; w.x = cvt_pk_bf16(r[0], r[1]); w.y = cvt_pk_bf16(r[2], r[3]); w.z = cvt_pk_bf16(r[4], r[5]); w.w = cvt_pk_bf16(r[6], r[7]);
                *(u32x4*)(O + (size_t)(row0 + ai * HALF + m * 16) * 3072 + ocol) = w; }
    }
};
struct EpiSiluMul {
    static constexpr int PERM = 1;
    bf16_t* O; int ldc; float* logits; int router_pn; float scl;
    __device__ __forceinline__ void operator()(const f32x4 (&acc)[2][2][4][2], const Unit& u, int tid_in, const LAS unsigned char* side) const {
        int t_ = tid_in; asm volatile("" : "+v"(t_));
        const int wid_ = __builtin_amdgcn_readfirstlane(t_ >> 6), wr = wid_ >> 2, wc = wid_ & 3, fr = t_ & 15, fq = (t_ & 63) >> 4;
        const int row0 = u.pm * BM + wr * 64 + fr, oc = wc * 32 + 8 * fq;
        if (u.pn == router_pn) {
            if (wc < 2) {
#pragma unroll
                for (int ai = 0; ai < 2; ++ai)
#pragma unroll
                    for (int m = 0; m < 4; ++m) { float* rp = logits + (size_t)(row0 + ai * HALF + m * 16) * NE + oc;
                        *(f32x4*)rp = acc[ai][0][m][0]; *(f32x4*)(rp + 4) = acc[ai][0][m][1]; }
            }
            return;
        }
#pragma unroll
        for (int ai = 0; ai < 2; ++ai)
#pragma unroll
            for (int m = 0; m < 4; ++m) { bf16_t* rowp = O + (size_t)(row0 + ai * HALF + m * 16) * ldc + u.pn * HALF + oc;
                float r[8];
#pragma unroll
                for (int n = 0; n < 2; ++n)
#pragma unroll
                    for (int j = 0; j < 4; ++j) r[n * 4 + j] = fast_silu(acc[ai][0][m][n][j] * scl) * (acc[ai][1][m][n][j] * scl);
                u32x4 w; w.x = cvt_pk_bf16(r[0], r[1]); w.y = cvt_pk_bf16(r[2], r[3]); w.z = cvt_pk_bf16(r[4], r[5]); w.w = cvt_pk_bf16(r[6], r[7]);
                *(u32x4*)rowp = w; }
    }
};
constexpr float A8_SCALE = 8.0f;
constexpr float Y8_SCALE = 16.0f;
__device__ __forceinline__ float clamp8(float v) { return __builtin_amdgcn_fmed3f(v, -448.0f, 448.0f); }
__device__ __forceinline__ unsigned pk4_fp8(float a, float b, float c, float d) { int w = __builtin_amdgcn_cvt_pk_fp8_f32(a, b, 0, false); w = __builtin_amdgcn_cvt_pk_fp8_f32(c, d, w, true); return (unsigned)w; }
constexpr float Y8M_SCALE = 2.0f;
__device__ __forceinline__ unsigned pk4_fp8c(float a, float b, float c, float d) { return pk4_fp8(clamp8(a * Y8M_SCALE), clamp8(b * Y8M_SCALE), clamp8(c * Y8M_SCALE), clamp8(d * Y8M_SCALE)); }
struct EpiSiluMul8 {
    static constexpr int PERM = 1;
    unsigned char* O; int ldc; float scl; int last_pn; int padc;
    __device__ __forceinline__ int nst(const Unit&) const { return 8; }
    __device__ __forceinline__ void operator()(const f32x4 (&acc)[2][2][4][2], const Unit& u, int tid_in, const LAS unsigned char* side) const {
        int t_ = tid_in; asm volatile("" : "+v"(t_));
        const int wid_ = __builtin_amdgcn_readfirstlane(t_ >> 6), wr = wid_ >> 2, wc = wid_ & 3, fr = t_ & 15, fq = (t_ & 63) >> 4;
        const int row0 = u.pm * BM + wr * 64 + fr, oc = wc * 32 + 8 * fq;
        const bool pad = (padc > 0) && (u.pn == last_pn);
#pragma unroll
        for (int ai = 0; ai < 2; ++ai)
#pragma unroll
            for (int m = 0; m < 4; ++m) { unsigned char* rowp = O + (size_t)(row0 + ai * HALF + m * 16) * ldc + u.pn * HALF + oc;
                float r[8];
#pragma unroll
                for (int n = 0; n < 2; ++n)
#pragma unroll
                    for (int j = 0; j < 4; ++j) r[n * 4 + j] = fast_silu(acc[ai][0][m][n][j] * scl) * (acc[ai][1][m][n][j] * (scl * A8_SCALE));
                u32x2 w; w.x = pk4_fp8(r[0], r[1], r[2], r[3]); w.y = pk4_fp8(r[4], r[5], r[6], r[7]);
                *(u32x2*)rowp = w;
                if (pad) *(u32x2*)(rowp + HALF) = (u32x2){0u, 0u}; }
    }
};
struct EpiScatterY {
    static constexpr int PERM = 2;
    unsigned char* Y; float wscl; int mode;
    __device__ __forceinline__ int nst(const Unit& u) const { return (u.nv == BM && !(PROBE_N > 0 && mode == 2)) ? 8 : 0; }
    __device__ __forceinline__ void operator()(const f32x4 (&acc)[2][2][4][2], const Unit& u, int tid_in, const LAS unsigned char* side) const {
        int t_ = tid_in; asm volatile("" : "+v"(t_));
        const int wid_ = __builtin_amdgcn_readfirstlane(t_ >> 6), wr = wid_ >> 2, wc = wid_ & 3, fr = t_ & 15, fq = (t_ & 63) >> 4;
        const int col0 = u.pn * BM + wc * 64 + 16 * fq;
#pragma unroll
        for (int ai = 0; ai < 2; ++ai)
#pragma unroll
            for (int m = 0; m < 4; ++m) { const int rl = wr * 64 + fr + ai * HALF + m * 16; int dst = rl < u.nv ? *(const LAS int*)(side + rl * 4) : -1; const float w = *(const LAS float*)(side + 1024 + rl * 4) * wscl;
                if (dst >= 0 && !(PROBE_N > 0 && mode == 2)) {
                    const f32x4 v0 = acc[ai][0][m][0] * w, v1 = acc[ai][0][m][1] * w, v2 = acc[ai][1][m][0] * w, v3 = acc[ai][1][m][1] * w;
                    u32x4 o; o.x = pk4_fp8(v0[0], v0[1], v0[2], v0[3]); o.y = pk4_fp8(v1[0], v1[1], v1[2], v1[3]); o.z = pk4_fp8(v2[0], v2[1], v2[2], v2[3]); o.w = pk4_fp8(v3[0], v3[1], v3[2], v3[3]);
                    *(u32x4*)(Y + (size_t)dst * DM + col0) = o; } }
    }
};
struct EpiFp8 {
    static constexpr bool PREFETCH = false;
    static constexpr int PERM = 2;
    unsigned char* O; int ldc; float scl;
    __device__ __forceinline__ int nst(const Unit&) const { return 8; }
    __device__ __forceinline__ void operator()(const f32x4 (&acc)[2][2][4][2], const Unit& u, int tid_in, const LAS unsigned char* side) const {
        int t_ = tid_in; asm volatile("" : "+v"(t_));
        const int wid_ = __builtin_amdgcn_readfirstlane(t_ >> 6), wr = wid_ >> 2, wc = wid_ & 3, fr = t_ & 15, fq = (t_ & 63) >> 4;
        const int row0 = u.pm * BM + wr * 64 + fr, col0 = u.pn * BM + wc * 64 + 16 * fq;
#pragma unroll
        for (int ai = 0; ai < 2; ++ai)
#pragma unroll
            for (int m = 0; m < 4; ++m) {
                const f32x4 v0 = acc[ai][0][m][0] * scl, v1 = acc[ai][0][m][1] * scl, v2 = acc[ai][1][m][0] * scl, v3 = acc[ai][1][m][1] * scl;
                u32x4 o; o.x = pk4_fp8(v0[0], v0[1], v0[2], v0[3]); o.y = pk4_fp8(v1[0], v1[1], v1[2], v1[3]); o.z = pk4_fp8(v2[0], v2[1], v2[2], v2[3]); o.w = pk4_fp8(v3[0], v3[1], v3[2], v3[3]);
                *(u32x4*)(O + (size_t)(row0 + ai * HALF + m * 16) * ldc + col0) = o; }
    }
};
struct EpiCombine {
    static constexpr int PERM = 0;
    const float* base; float* out; const float* gate; const bf16_t* Y;
    __device__ __forceinline__ void operator()(const f32x4 (&acc)[2][2][4][2], const Unit& u, int tid_in, const LAS unsigned char* side) const {
        int t_ = tid_in; asm volatile("" : "+v"(t_));
        const int wid_ = __builtin_amdgcn_readfirstlane(t_ >> 6), wr = wid_ >> 2, wc = wid_ & 3, fr = t_ & 15, fq = (t_ & 63) >> 4;
        const int row0 = u.pm * BM + wr * 64 + fr, col0 = u.pn * BM + wc * 32 + 4 * fq;
        const float* gp = gate + (size_t)(u.pm >> 3) * DM + col0;
        f32x4 gv[2][2];
#pragma unroll
        for (int bj = 0; bj < 2; ++bj)
#pragma unroll
            for (int n = 0; n < 2; ++n) gv[bj][n] = *(const f32x4*)(gp + bj * HALF + n * 16);
#pragma unroll
        for (int ai = 0; ai < 2; ++ai)
#pragma unroll
            for (int m = 0; m < 4; ++m) { const int r = row0 + ai * HALF + m * 16; const size_t off = (size_t)r * DM + col0; const bf16_t* yp = Y + (size_t)r * (TOPK * DM) + col0;
#pragma unroll
                for (int bj = 0; bj < 2; ++bj)
#pragma unroll
                    for (int n = 0; n < 2; ++n) { const int co = bj * HALF + n * 16;
                        f32x4 s = acc[ai][bj][m][n];
#pragma unroll
                        for (int k = 0; k < TOPK; ++k) { const u32x2 y = *(const u32x2*)(yp + (size_t)k * DM + co); s[0] += bf_lo(y.x); s[1] += bf_hi(y.x); s[2] += bf_lo(y.y); s[3] += bf_hi(y.y); }
                        const f32x4 bs = *(const f32x4*)(base + off + co);
                        *(f32x4*)(out + off + co) = bs + gv[bj][n] * s; }
                asm volatile("" ::: "memory"); }
    }
};

template <class Epi, class Sched, int K, bool GATHER, int ES = 2, bool ALIGN_EPI = true, int LDA = 0, int LDB = 0, bool ZLAST = false>
__device__ __forceinline__ void gemm_phase(LAS unsigned char* lds, const Sched& S, const Epi& E, const int tid) {
    const int wid = __builtin_amdgcn_readfirstlane(tid >> 6), lane = tid & 63, wr = wid >> 2, wc = wid & 3, fr = lane & 15, fq = lane >> 4;
    constexpr int PA = LDA ? LDA : K * ES, PB = LDB ? LDB : K * ES;
    constexpr int BKE = BK * 2 / ES;
    constexpr int nt = K / BKE;
    static_assert(K % (2 * BKE) == 0 && K >= 4 * BKE, "K");
    unsigned voffA[2], voffB[2][2]; int RA[2]; unsigned CA2[2];
#pragma unroll
    for (int i = 0; i < 2; ++i) { int R, C; stage_rc(tid * 16 + i * 8192, R, C);
        voffA[i] = (unsigned)(R * PA + C * 2); RA[i] = R; CA2[i] = (unsigned)C * 2u;
#pragma unroll
        for (int h = 0; h < 2; ++h) { const int Rb = Epi::PERM == 2 ? (64 * (R >> 5) + 16 * ((R & 15) >> 2) + 8 * h + 4 * ((R >> 4) & 1) + (R & 3)) : (h * HALF + (Epi::PERM == 1 ? ((R & ~31) + perm32(R & 31)) : R));
            voffB[h][i] = (unsigned)(Rb * PB + C * 2); } }
    constexpr size_t kstep = (size_t)(BK * 2);
    constexpr size_t hstep = (size_t)HALF * PA;
    const unsigned ldsw = (unsigned)wid * 1024u;
    const int aoff = lds_byte(wr * 64 + fr, fq * 8), boff = lds_byte(wc * 32 + fr, fq * 8);
    constexpr int KST = 1024;
#define PG8_SA(b, h) (((b) * 2 + (h)) * HTB)
#define PG8_SB(b, h) ((4 + (b) * 2 + (h)) * HTB)
#define PG8_STAGE(bufoff, gbase, voff) do { const char* _gb = (const char*)(gbase); asm volatile("" : "+s"(_gb)); _Pragma("unroll") for (int _i = 0; _i < 2; ++_i) { \
        unsigned _vo = (voff)[_i]; asm volatile("" : "+v"(_vo)); __builtin_amdgcn_global_load_lds((const unsigned*)(_gb + _vo), (LAS unsigned*)(lds + (bufoff) + ldsw + _i * 8192), 16, 0, 0); } } while (0)
#define PG8_STAGE_A(bufoff, h, p, go) do { if constexpr (GATHER) { PG8_STAGE(bufoff, p, (go)[h]); } else { PG8_STAGE(bufoff, (p) + (h) * hstep, voffA); } } while (0)
#define PG8_STAGE_B(bufoff, h, p) PG8_STAGE(bufoff, p, voffB[h])
#define PG8_LDA(dst, b, h) do { _Pragma("unroll") for (int m = 0; m < 4; ++m) _Pragma("unroll") for (int k = 0; k < 2; ++k) dst[m][k] = *(const LAS bf16x8*)(lds + PG8_SA(b, h) + aoff + m * 2048 + k * KST); } while (0)
#define PG8_LDB(dst, b, h) do { _Pragma("unroll") for (int n = 0; n < 2; ++n) _Pragma("unroll") for (int k = 0; k < 2; ++k) dst[n][k] = *(const LAS bf16x8*)(lds + PG8_SB(b, h) + boff + n * 2048 + k * KST); } while (0)
#define PG8_MMA(ai, bj, At, Bt) do { __builtin_amdgcn_s_setprio(1); _Pragma("unroll") for (int m = 0; m < 4; ++m) _Pragma("unroll") for (int n = 0; n < 2; ++n) { \
        if constexpr (ES == 2) { _Pragma("unroll") for (int k = 0; k < 2; ++k) acc[ai][bj][m][n] = __builtin_amdgcn_mfma_f32_16x16x32_bf16(Bt[n][k], At[m][k], acc[ai][bj][m][n], 0, 0, 0); } \
        else { acc[ai][bj][m][n] = __builtin_amdgcn_mfma_scale_f32_16x16x128_f8f6f4(__builtin_shufflevector((i32x4)Bt[n][0], (i32x4)Bt[n][1], 0, 1, 2, 3, 4, 5, 6, 7), \
                                                                                     __builtin_shufflevector((i32x4)At[m][0], (i32x4)At[m][1], 0, 1, 2, 3, 4, 5, 6, 7), acc[ai][bj][m][n], 0, 0, 0, 0, 0, 0); } } \
        __builtin_amdgcn_s_setprio(0); } while (0)
#define PG8_SIDE(u, idx) do { if constexpr (Sched::SIDE) { const int* _sp = S.side_ptr(u, wid); int _t = tid; asm volatile("" : "+v"(_t)); const unsigned _l4 = (unsigned)(_t & 63) * 4u;     \
        __builtin_amdgcn_global_load_lds((const unsigned*)((const char*)_sp + _l4), (LAS unsigned*)(lds + SIDE_ROWS + ((idx) % 3) * 2048 + wid * 256), 4, 0, 0); } } while (0)
#define PG8_WAIT_V(n) asm volatile("s_waitcnt vmcnt(" #n ")" ::: "memory")
#define PG8_WAIT_L(n) asm volatile("s_waitcnt lgkmcnt(" #n ")" ::: "memory")
#define PG8_BAR __builtin_amdgcn_s_barrier()
#define PG8_SCHED __builtin_amdgcn_sched_barrier(0)
#define PG8_WAIT_VS(n0, n8, n16) do { if (lzt == 0) PG8_WAIT_V(n0); else if (lzt == 8) PG8_WAIT_V(n8); else PG8_WAIT_V(n16); } while (0)
    Unit cur, nxt; int ui = 0; int lz = 0;
    if (!S.next(0, cur)) return;
    f32x4 acc[2][2][4][2];
#pragma unroll
    for (int a = 0; a < 2; ++a)
#pragma unroll
        for (int b = 0; b < 2; ++b)
#pragma unroll
            for (int m = 0; m < 4; ++m)
#pragma unroll
                for (int n = 0; n < 2; ++n) acc[a][b][m][n] = (f32x4){0.f, 0.f, 0.f, 0.f};
    bf16x8 At[4][2], B0[2][2], B1[2][2];
    unsigned gcur[2][2] = {{0u, 0u}, {0u, 0u}};
    const char* cA = S.a_ptr(cur); const char* cB = S.b_ptr(cur);
    if constexpr (GATHER) { const int* rl = S.side0 + (size_t)cur.rb;
#pragma unroll
        for (int h = 0; h < 2; ++h)
#pragma unroll
            for (int i = 0; i < 2; ++i) { const int ri = h * HALF + RA[i]; const int tk = ri < cur.nv ? rl[ri] : 0;
                gcur[h][i] = (unsigned)tk * (unsigned)PA + CA2[i]; asm volatile("" : "+v"(gcur[h][i])); } }
    PG8_SIDE(cur, 0);
    PG8_STAGE_B(PG8_SB(0, 0), 0, cB); PG8_STAGE_B(PG8_SB(0, 1), 1, cB); PG8_STAGE_A(PG8_SA(0, 0), 0, cA, gcur); PG8_STAGE_A(PG8_SA(0, 1), 1, cA, gcur);
    if (wr == 1) PG8_BAR;
    PG8_WAIT_V(2); PG8_BAR;
    PG8_STAGE_B(PG8_SB(1, 0), 0, cB + kstep); PG8_STAGE_A(PG8_SA(1, 0), 0, cA + kstep, gcur); PG8_STAGE_B(PG8_SB(1, 1), 1, cB + kstep);
    PG8_WAIT_V(6); PG8_BAR;
    for (;;) {
        const bool has_next = S.next(ui + 1, nxt);
        const char* nA = has_next ? S.a_ptr(nxt) : cA; const char* nB = has_next ? S.b_ptr(nxt) : cB;
        if (has_next) PG8_SIDE(nxt, ui + 1);
#pragma nounroll
        for (int t = 0; t < nt; t += 2) {
            const bool last = (t == nt - 2);
            const int lzt = (t == 0) ? lz : 0;
            const char* a1 = cA + (size_t)(t + 1) * kstep;
            const char* a2 = last ? nA : cA + (size_t)(t + 2) * kstep; const char* b2 = last ? nB : cB + (size_t)(t + 2) * kstep;
            const char* a3 = a2 + kstep; const char* b3 = b2 + kstep;
            static_assert(!GATHER || nt >= 4, "gather needs a few K-tiles of lead for the side list");
            PG8_LDB(B0, 0, 0); PG8_LDB(B1, 0, 1); PG8_SCHED; PG8_LDA(At, 0, 0); if (!(t == 0 && ui > 0) && !(ZLAST && last)) PG8_STAGE_A(PG8_SA(1, 1), 1, a1, gcur);
            if constexpr (GATHER) { if (last && has_next) {
                int t2_ = tid; asm volatile("" : "+v"(t2_));
#pragma unroll
                for (int i = 0; i < 2; ++i) { int R, C; stage_rc(t2_ * 16 + i * 8192, R, C);
#pragma unroll
                    for (int h = 0; h < 2; ++h) { const int ri = h * HALF + R; const int tk = ri < nxt.nv ? *(const LAS int*)(lds + SIDE_ROWS + ((ui + 1) % 3) * 2048 + ri * 4) : 0;
                        gcur[h][i] = (unsigned)tk * (unsigned)PA + (unsigned)C * 2u; } } } }
            if (ZLAST && last) PG8_WAIT_V(0); else PG8_WAIT_VS(8, 16, 24);
            PG8_WAIT_L(0); PG8_BAR; PG8_MMA(0, 0, At, B0); PG8_MMA(0, 1, At, B1); PG8_BAR; PG8_SCHED;
            PG8_LDA(At, 0, 1); PG8_STAGE_B(PG8_SB(0, 0), 0, b2); PG8_STAGE_B(PG8_SB(0, 1), 1, b2); PG8_STAGE_A(PG8_SA(0, 0), 0, a2, gcur);
            PG8_WAIT_VS(8, 16, 24);
            PG8_WAIT_L(0); PG8_BAR; PG8_MMA(1, 0, At, B0); PG8_MMA(1, 1, At, B1); PG8_BAR; PG8_SCHED;
            const bool zskip = ZLAST && last;
            if (!zskip) { PG8_LDB(B0, 1, 0); PG8_LDB(B1, 1, 1); PG8_SCHED; PG8_LDA(At, 1, 0); } PG8_STAGE_A(PG8_SA(0, 1), 1, a2, gcur);
            PG8_WAIT_VS(8, 16, 24); PG8_WAIT_L(0); PG8_BAR; if (!zskip) { PG8_MMA(0, 0, At, B0); PG8_MMA(0, 1, At, B1); } PG8_BAR; PG8_SCHED;
            if (!zskip) { PG8_LDA(At, 1, 1); } if (!(ZLAST && !last)) { PG8_STAGE_B(PG8_SB(1, 0), 0, b3); PG8_STAGE_B(PG8_SB(1, 1), 1, b3); PG8_STAGE_A(PG8_SA(1, 0), 0, a3, gcur); }
            if constexpr (ZLAST) { static_assert(!ZLAST || nt == 4, "ZLAST: hand-counted for four K-tiles"); if (last) PG8_WAIT_V(8); else PG8_WAIT_V(2); }
            else PG8_WAIT_V(8);
            PG8_WAIT_L(0); PG8_BAR; if (!zskip) { PG8_MMA(1, 0, At, B0); PG8_MMA(1, 1, At, B1); } PG8_BAR; PG8_SCHED;
            if (last && has_next) PG8_STAGE_A(PG8_SA(1, 1), 1, a3, gcur);
        }
        if constexpr (ALIGN_EPI) { if (wr == 0) PG8_BAR; }
        E(acc, cur, tid, lds + SIDE_ROWS + (ui % 3) * 2048);
        if (!has_next) break;
        lz = E.nst(cur);
#pragma unroll
        for (int a = 0; a < 2; ++a)
#pragma unroll
            for (int b = 0; b < 2; ++b)
#pragma unroll
                for (int m = 0; m < 4; ++m)
#pragma unroll
                    for (int n = 0; n < 2; ++n) acc[a][b][m][n] = (f32x4){0.f, 0.f, 0.f, 0.f};
        cur = nxt; cA = nA; cB = nB; ++ui;
        if constexpr (ALIGN_EPI) { if (wr == 1) PG8_BAR; }
    }
    PG8_WAIT_V(0);
    if constexpr (!ALIGN_EPI) { if (wr == 0) PG8_BAR; }
    PG8_BAR;
#undef PG8_SA
#undef PG8_SB
#undef PG8_STAGE
#undef PG8_STAGE_A
#undef PG8_STAGE_B
#undef PG8_SIDE
#undef PG8_LDA
#undef PG8_LDB
#undef PG8_MMA
#undef PG8_WAIT_V
#undef PG8_WAIT_VS
#undef PG8_WAIT_L
#undef PG8_BAR
#undef PG8_SCHED
}
}

struct Args { const float* in[31]; float* out; unsigned char* ws; int ph_lo, ph_hi; int probe, pad; };
enum { I_X = 0, I_C, I_ADAW, I_ADAB, I_NMIXG, I_NFFNG, I_ABWIN, I_SGULNG, I_SGULNB, I_SGUW, I_SGUB, I_POOLW, I_POOLSC, I_ABWOUT, I_CDWIN, I_C3W, I_C3B, I_C31W, I_C31B, I_CDLNG, I_CDLNB, I_CDWOUT,
       I_RW, I_RB, I_EW1, I_EW3, I_EW2, I_SW1, I_SW3, I_SW2, I_FG };

__device__ __forceinline__ void ph_mod_partial(const float* c, const float* ada_w, float* modp, LAS unsigned char* lds, int blk, int nblk, const int tid) {
    const int wave = __builtin_amdgcn_readfirstlane(tid >> 6), lane = tid & 63;
    LAS float* red = (LAS float*)lds;
    for (int task = blk; task < 768; task += nblk) {
        const int l = task / 384, rem = task % 384, nb = rem >> 2, kq = rem & 3;
        const int k0 = kq * 512 + wave * 64;
        int cv[16];
#pragma unroll
        for (int b = 0; b < 16; ++b) { const float x = c[b * DM + k0 + lane]; cv[b] = __builtin_bit_cast(int, x / (1.0f + __expf(-x))); }
        f32x2 acc[16];
#pragma unroll
        for (int b = 0; b < 16; ++b) acc[b] = (f32x2){0.f, 0.f};
        const float* wp = ada_w + ((size_t)l * DM + k0) * (6 * DM) + nb * 128 + lane * 2;
#pragma unroll 8
        for (int kk = 0; kk < 64; ++kk) {
            const f32x2 w = *(const f32x2*)(wp + (size_t)kk * (6 * DM));
#pragma unroll
            for (int b = 0; b < 16; ++b) { const float s = __builtin_bit_cast(float, __builtin_amdgcn_readlane(cv[b], kk)); acc[b] += w * s; }
        }
#pragma unroll
        for (int b = 0; b < 16; ++b) *(LAS f32x2*)(red + (wave * 16 + b) * 128 + lane * 2) = acc[b];
        __syncthreads();
        { const int b = tid >> 5, c4 = tid & 31;
            f32x4 s = (f32x4){0.f, 0.f, 0.f, 0.f};
#pragma unroll
            for (int w = 0; w < 8; ++w) s += *(const LAS f32x4*)(red + (w * 16 + b) * 128 + c4 * 4);
            *(f32x4*)(modp + ((size_t)((kq * 2 + l) * 16 + b)) * (6 * DM) + nb * 128 + c4 * 4) = s; }
        __syncthreads();
    }
}
__device__ __forceinline__ void ph_mod_final(const float* modp, const float* ada_b, float* modf, int gtid, int ngt) {
    for (int i = gtid; i < 2 * 6 * 16 * DM; i += ngt) {
        const int d = i & (DM - 1), b = (i >> 11) & 15, j = (i >> 15) % 6, l = i / (6 * 16 * DM);
        const size_t src = ((size_t)(l * 16 + b)) * (6 * DM) + j * DM + d;
        float s = ada_b[l * 6 * DM + j * DM + d];
#pragma unroll
        for (int kq = 0; kq < 4; ++kq) s += modp[(size_t)kq * (2 * 16 * 6 * DM) + src];
        if (j == 1 || j == 4) s += 1.0f;
        modf[i] = s;
    }
}
__device__ __forceinline__ void conv_item(const float* W, int N, int k0, int n0, bf16_t* dst, int ldd, LAS float* scr, int lane) {
    float wv[32];
#pragma unroll
    for (int i = 0; i < 32; ++i) { const int kk = 2 * i + (lane >> 5); wv[i] = W[(size_t)(k0 + kk) * N + n0 + (lane & 31)]; }
#pragma unroll
    for (int i = 0; i < 32; ++i) { const int kk = 2 * i + (lane >> 5); scr[kk * 33 + (lane & 31)] = wv[i]; }
    LDS_WAIT(); asm volatile("" ::: "memory");
    const int c = lane & 7;
#pragma unroll
    for (int j = 0; j < 4; ++j) { const int n = (lane >> 3) + 8 * j; const LAS float* s = scr + (8 * c) * 33 + n;
        u32x4 o; o.x = cvt_pk_bf16(s[0 * 33], s[1 * 33]); o.y = cvt_pk_bf16(s[2 * 33], s[3 * 33]); o.z = cvt_pk_bf16(s[4 * 33], s[5 * 33]); o.w = cvt_pk_bf16(s[6 * 33], s[7 * 33]);
        *(u32x4*)(dst + (size_t)n * ldd + k0 + 8 * c) = o; }
    LDS_WAIT(); asm volatile("" ::: "memory");
}
constexpr float W8_SCALE = 64.0f;
__device__ __forceinline__ void conv_item8(const float* W, int N, int k0, int n0, unsigned char* dst, int ldd, LAS float* scr, int lane) {
    float wv[32];
#pragma unroll
    for (int i = 0; i < 32; ++i) { const int kk = 2 * i + (lane >> 5); wv[i] = W[(size_t)(k0 + kk) * N + n0 + (lane & 31)]; }
#pragma unroll
    for (int i = 0; i < 32; ++i) { const int kk = 2 * i + (lane >> 5); scr[kk * 33 + (lane & 31)] = wv[i]; }
    LDS_WAIT(); asm volatile("" ::: "memory");
    const int c = lane & 7;
#pragma unroll
    for (int j = 0; j < 4; ++j) { const int n = (lane >> 3) + 8 * j; const LAS float* sp = scr + (8 * c) * 33 + n;
        u32x2 o; o.x = pg8::pk4_fp8(sp[0 * 33] * W8_SCALE, sp[1 * 33] * W8_SCALE, sp[2 * 33] * W8_SCALE, sp[3 * 33] * W8_SCALE); o.y = pg8::pk4_fp8(sp[4 * 33] * W8_SCALE, sp[5 * 33] * W8_SCALE, sp[6 * 33] * W8_SCALE, sp[7 * 33] * W8_SCALE);
        *(u32x2*)(dst + (size_t)n * ldd + k0 + 8 * c) = o; }
    LDS_WAIT(); asm volatile("" ::: "memory");
}
__device__ __forceinline__ void conv_gated8(const float* W, int K, int N, unsigned char* WT, int half, int item, LAS float* scr, int lane) {
    const int nblk = N / 32, kb = item / nblk, nb = item % nblk, n0 = 32 * nb;
    conv_item8(W, N, 64 * kb, n0, WT + (size_t)((n0 >> 7) * 256 + half * 128 + (n0 & 127)) * K, K, scr, lane);
}
__device__ __forceinline__ void conv_plain(const float* W, int K, int N, bf16_t* WT, int item, LAS float* scr, int lane) {
    const int nblk = N / 32, kb = item / nblk, nb = item % nblk;
    conv_item(W, N, 64 * kb, 32 * nb, WT + (size_t)(32 * nb) * K, K, scr, lane);
}
__device__ __forceinline__ void conv_gated(const float* W, int K, int N, bf16_t* WT, int half, int item, LAS float* scr, int lane) {
    const int nblk = N / 32, kb = item / nblk, nb = item % nblk, n0 = 32 * nb;
    conv_item(W, N, 64 * kb, n0, WT + (size_t)((n0 >> 7) * 256 + half * 128 + (n0 & 127)) * K, K, scr, lane);
}
constexpr int CV_N13 = NE * 2 * (DM / 64) * (EFF / 32), CV_N2 = NE * (EFF / 64) * (DM / 32), CV_TOT = CV_N13 + CV_N2;
#ifndef NCV_IN
#define NCV_IN 36
#define NCV_OUT 48
#define NCV_E1 24
#define NCV_IN1 40
#define CVQ_P0 25728
#define CVQ_A1 44928
#define CVQ_C 12600
#endif
struct CJob { const float* src; unsigned char* dst; int N, ldd; };
__device__ __forceinline__ CJob conv_job(const float* w1, const float* w3, const float* w2, int l, unsigned char* WE13, unsigned char* WE2, int it) {
    constexpr int I13 = (DM / 64) * (EFF / 32), I2 = (EFF / 64) * (DM / 32);
    CJob j;
    if (it < CV_N13) { const int e = it / (2 * I13); int r = it % (2 * I13); const int half = r >= I13 ? 1 : 0; r -= half * I13; const int nblk = EFF / 32, kb = r / nblk, n0 = 32 * (r % nblk);
        const size_t eo = (size_t)(l * NE + e) * DM * EFF;
        j.src = (half ? w3 : w1) + eo + (size_t)(64 * kb) * EFF + n0; j.N = EFF; j.ldd = DM;
        j.dst = WE13 + (size_t)e * 768 * DM + (size_t)((n0 >> 7) * 256 + half * 128 + (n0 & 127)) * DM + 64 * kb; }
    else { const int q = it - CV_N13, e = q / I2, r = q % I2; const int nblk = DM / 32, kb = r / nblk, n0 = 32 * (r % nblk);
        const size_t eo = (size_t)(l * NE + e) * DM * EFF;
        j.src = w2 + eo + (size_t)(64 * kb) * DM + n0; j.N = DM; j.ldd = 512;
        j.dst = WE2 + (size_t)e * DM * 512 + (size_t)n0 * 512 + 64 * kb; }
    return j;
}
__device__ __forceinline__ void conv_load(const CJob& j, float (&wv)[32], int lane) {
    const float* p = j.src + (size_t)((lane >> 5) * 32) * j.N + (lane & 31);
#pragma unroll
    for (int i = 0; i < 32; ++i) wv[i] = p[(size_t)i * j.N];
}
constexpr int CVP = 20;
__device__ __forceinline__ void conv_finish8(const CJob& j, const float (&wv)[32], LAS float* scr_, int lane) {
    LAS unsigned* scr = (LAS unsigned*)scr_;
    const int n = lane & 31, kh = lane >> 5;
#pragma unroll
    for (int i = 0; i < 8; ++i) scr[n * CVP + kh * 8 + i] = pg8::pk4_fp8(wv[4 * i] * W8_SCALE, wv[4 * i + 1] * W8_SCALE, wv[4 * i + 2] * W8_SCALE, wv[4 * i + 3] * W8_SCALE);
    LDS_WAIT(); asm volatile("" ::: "memory");
#pragma unroll
    for (int q = 0; q < 2; ++q) { const int r = (lane >> 2) + 16 * q, c = lane & 3;
        const u32x4 o = *(const LAS u32x4*)(scr + r * CVP + 4 * c);
        *(u32x4*)(j.dst + (size_t)r * j.ldd + 16 * c) = o; }
    LDS_WAIT(); asm volatile("" ::: "memory");
}
__device__ __forceinline__ void conv_range(const float* w1, const float* w3, const float* w2, int l, unsigned char* WE13, unsigned char* WE2, LAS float* scr, int first, int stride, int lo, int hi, int lane) {
    int it = lo + first;
    if (it < hi) {
        CJob a = conv_job(w1, w3, w2, l, WE13, WE2, it); float wa[32]; conv_load(a, wa, lane);
        for (;;) { const int nx = it + stride; const bool more = nx < hi;
            const CJob b = conv_job(w1, w3, w2, l, WE13, WE2, more ? nx : it); float wb[32]; conv_load(b, wb, lane);
            conv_finish8(a, wa, scr, lane);
            if (!more) break;
            a = b; it = nx;
#pragma unroll
            for (int i = 0; i < 32; ++i) wa[i] = wb[i]; }
    }
}
__device__ __forceinline__ void conv_experts(const float* w1, const float* w3, const float* w2, int l, bf16_t* WE13, bf16_t* WE2, LAS float* scr, int gw, int ngw, int lane) {
    conv_range(w1, w3, w2, l, (unsigned char*)WE13, (unsigned char*)WE2, scr, gw, ngw, 0, CV_TOT, lane);
}
typedef const __attribute__((address_space(4))) char* kptr_t0;
#define KIN(i) (*(const float* const __attribute__((address_space(4)))*)(kp + 8 * (i)))
__device__ __forceinline__ void ph_convert_misc(kptr_t0 kp, unsigned char* ws, LAS float* scr, int gw, int ngw, int lane, int gtid, int ngt) {
    constexpr int I_ABIN = 32 * 96, I_SQ = 32 * 64, I_CDIN = 32 * 160, I_SH = 32 * 16, I_RT = 32 * 2, I_SH2 = 8 * 64, I_PL = 4 * 8;
    constexpr int TOT = I_ABIN + I_SQ + I_CDIN + I_SQ + 2 * (2 * I_SH + I_RT + I_SH2) + 4 * I_PL;
    for (int it = gw; it < TOT; it += ngw) {
        int r = it;
        if (r < I_ABIN) { if ((r % 96) < 64) { const int kb = r / 96, nb = r % 96; conv_item8(KIN(I_ABWIN), 3072, 64 * kb, 32 * nb, ws + WS_WABIN + (size_t)(32 * nb) * DM, DM, scr, lane); } continue; } r -= I_ABIN;
        if (r < I_SQ) { const int kb = r / 64, nb = r % 64; conv_item8(KIN(I_ABWOUT), DM, 64 * kb, 32 * nb, ws + WS_WABOUT + (size_t)(32 * nb) * DM, DM, scr, lane); continue; } r -= I_SQ;
        if (r < I_CDIN) {
            const int nblk = 5120 / 32, kb = r / nblk, n0 = 32 * (r % nblk); int drow = n0;
            if (n0 >= 1024) { const int base = n0 < 3072 ? 1024 : 3072, rel = n0 - base, seg = rel >> 10, c = rel & 1023; drow = base + (c >> 7) * 256 + seg * 128 + (c & 127); }
            conv_item8(KIN(I_CDWIN), 5120, 64 * kb, n0, ws + WS_WCDIN + (size_t)drow * DM, DM, scr, lane); continue; } r -= I_CDIN;
        if (r < I_SQ) { const int kb = r / 64, nb = r % 64; conv_item8(KIN(I_CDWOUT), DM, 64 * kb, 32 * nb, ws + WS_WCDOUT + (size_t)(32 * nb) * DM, DM, scr, lane); continue; } r -= I_SQ;
        bool done = false;
#pragma unroll
        for (int l = 0; l < 2; ++l) {
            if (done) break;
            bf16_t* sh1 = (bf16_t*)(ws + WS_WSH1) + (size_t)l * 1280 * DM; bf16_t* sh2 = (bf16_t*)(ws + WS_WSH2) + (size_t)l * DM * SFF;
            if (r < I_SH) { conv_gated8(KIN(I_SW1) + (size_t)l * DM * SFF, DM, SFF, ws + WS_WSH1F8 + (size_t)l * 1024 * DM, 0, r, scr, lane); done = true; break; } r -= I_SH;
            if (r < I_SH) { conv_gated8(KIN(I_SW3) + (size_t)l * DM * SFF, DM, SFF, ws + WS_WSH1F8 + (size_t)l * 1024 * DM, 1, r, scr, lane); done = true; break; } r -= I_SH;
            if (r < I_RT) { conv_plain(KIN(I_RW) + (size_t)l * DM * NE, DM, NE, sh1 + (size_t)1024 * DM, r, scr, lane); done = true; break; } r -= I_RT;
            if (r < I_SH2) { const int nblk = DM / 32, kb = r / nblk, nb = r % nblk; conv_item8(KIN(I_SW2) + (size_t)l * SFF * DM, DM, 64 * kb, 32 * nb, ws + WS_WSH2F8 + (size_t)l * DM * SFF + (size_t)(32 * nb) * SFF, SFF, scr, lane); done = true; break; } r -= I_SH2;
        }
        if (done) continue;
        { const int g = r / I_PL; conv_plain(KIN(I_POOLW) + (size_t)g * 65536, 256, 256, (bf16_t*)(ws + WS_WPOOL) + (size_t)g * 65536, r % I_PL, scr, lane); }
    }
    for (int i = gtid; i < 2 * 192 * DM / 8; i += ngt) { const int l = i / (192 * DM / 8), o = i % (192 * DM / 8);
        *(u32x4*)((bf16_t*)(ws + WS_WSH1) + (size_t)l * 1280 * DM + (size_t)1088 * DM + (size_t)o * 8) = (u32x4){0u, 0u, 0u, 0u}; }
    for (int i = gtid; i < 8 * 128 * 128 / 2; i += ngt) { const int e0 = i * 2, ii = (e0 >> 7) & 127, jj = e0 & 127; const bool ok = (ii >> 6) >= (jj >> 6);
        const f32x2 v = *(const f32x2*)(KIN(I_SGUW) + e0); ((unsigned*)(ws + WS_WSGU))[i] = ok ? cvt_pk_bf16(v.x, v.y) : 0u; }
}
__device__ __forceinline__ void ph_fold_pool(const float* w_in, const float* pool_w, const float* pool_scale, unsigned char* WT, LAS unsigned char* lds, int blk, int nblk, const int tid) {
    LAS float* wl = (LAS float*)lds;
    const int d = tid & 255, kh = tid >> 8;
    for (int task = blk; task < 4 * 64; task += nblk) { const int g = task >> 6, k0 = (task & 63) * 32;
#pragma unroll
        for (int j = 0; j < 4; ++j) { const int q = tid + 512 * j, kk = q >> 6, c4 = q & 63;
            *(LAS f32x4*)(wl + kk * 256 + c4 * 4) = *(const f32x4*)(w_in + (size_t)(k0 + kk) * 3072 + 2048 + g * 256 + c4 * 4); }
        __syncthreads();
        float acc[16];
#pragma unroll
        for (int kk = 0; kk < 16; ++kk) acc[kk] = 0.f;
        const float* pw = pool_w + (size_t)g * 65536 + d;
#pragma unroll 2
        for (int c = 0; c < 256; c += 4) { const float p0 = pw[(size_t)c * 256], p1 = pw[(size_t)(c + 1) * 256], p2 = pw[(size_t)(c + 2) * 256], p3 = pw[(size_t)(c + 3) * 256];
#pragma unroll
            for (int kk = 0; kk < 16; ++kk) { const f32x4 wv = *(const LAS f32x4*)(wl + (kh * 16 + kk) * 256 + c); acc[kk] += (wv[0] * p0 + wv[1] * p1) + (wv[2] * p2 + wv[3] * p3); } }
        const float sc = pool_scale[g * 256 + d] * W8_SCALE;
        u32x4 o;
#pragma unroll
        for (int q = 0; q < 4; ++q) o[q] = pg8::pk4_fp8(acc[4 * q] * sc, acc[4 * q + 1] * sc, acc[4 * q + 2] * sc, acc[4 * q + 3] * sc);
        *(u32x4*)(WT + (size_t)(2048 + g * 256 + d) * DM + k0 + kh * 16) = o;
        __syncthreads();
    }
}
__device__ __forceinline__ void ph_norm(const float* x, const float* g, const float* sc1p, const float* sh, unsigned char* h8, int gw, int ngw, int lane) {
    for (int row0 = gw * 4; row0 < NTOK; row0 += ngw * 4) {
        const int b = row0 >> 11;
        const f32x4* g4 = (const f32x4*)g + lane; const f32x4* s4 = (const f32x4*)(sc1p + (size_t)b * DM) + lane; const f32x4* h4 = (const f32x4*)(sh + (size_t)b * DM) + lane;
        f32x4 v[4][8]; float ss[4];
#pragma unroll
        for (int r = 0; r < 4; ++r) { const f32x4* xr = (const f32x4*)(x + (size_t)(row0 + r) * DM) + lane;
#pragma unroll
            for (int j = 0; j < 8; ++j) v[r][j] = xr[64 * j]; }
#pragma unroll
        for (int r = 0; r < 4; ++r) { float a = 0.f;
#pragma unroll
            for (int j = 0; j < 8; ++j) a += (v[r][j][0] * v[r][j][0] + v[r][j][1] * v[r][j][1]) + (v[r][j][2] * v[r][j][2] + v[r][j][3] * v[r][j][3]);
            ss[r] = a; }
#pragma unroll
        for (int r = 0; r < 4; ++r) ss[r] = wave_sum(ss[r], lane);
        float rstd[4];
#pragma unroll
        for (int r = 0; r < 4; ++r) rstd[r] = __builtin_amdgcn_rsqf(ss[r] * (1.0f / DM) + EPS);
#pragma unroll
        for (int j = 0; j < 8; ++j) { const f32x4 gs = g4[64 * j] * s4[64 * j], hh = h4[64 * j];
#pragma unroll
            for (int r = 0; r < 4; ++r) { const f32x4 o4 = v[r][j] * rstd[r] * gs + hh;
                ((unsigned*)(h8 + (size_t)(row0 + r) * DM) + lane)[64 * j] = pg8::pk4_fp8(o4[0], o4[1], o4[2], o4[3]); } }
    }
}
__device__ __forceinline__ void ph_final_norm(float* x, const float* g, int gw, int ngw, int lane) {
    for (int row = gw; row < NTOK; row += ngw) {
        f32x4* xr = (f32x4*)(x + (size_t)row * DM) + lane;
        f32x4 v[8]; float ss = 0.f;
#pragma unroll
        for (int j = 0; j < 8; ++j) { v[j] = xr[64 * j]; ss += (v[j][0] * v[j][0] + v[j][1] * v[j][1]) + (v[j][2] * v[j][2] + v[j][3] * v[j][3]); }
        const float rstd = __builtin_amdgcn_rsqf(wave_sum(ss, lane) * (1.0f / DM) + EPS);
        const f32x4* g4 = (const f32x4*)g + lane;
#pragma unroll
        for (int j = 0; j < 8; ++j) xr[64 * j] = v[j] * rstd * g4[64 * j];
    }
}

template <int N> struct RsStep {
    static __device__ __forceinline__ float run(const float (&v)[N], int lane) {
        constexpr int H = N / 2; float nv[H]; const bool up = (lane & H) != 0;
#pragma unroll
        for (int i = 0; i < H; ++i) { const float send = up ? v[i] : v[i + H], keep = up ? v[i + H] : v[i]; nv[i] = keep + shfl_xor_l(send, H, lane); }
        return RsStep<H>::run(nv, lane);
    }
};
template <> struct RsStep<1> { static __device__ __forceinline__ float run(const float (&v)[1], int) { return v[0]; } };
template <int NV> __device__ __forceinline__ void reduce_scatter(float (&v)[NV], int lane) {
#pragma unroll
    for (int off = 32; off >= NV; off >>= 1) {
#pragma unroll
        for (int i = 0; i < NV; ++i) v[i] += shfl_xor_l(v[i], off, lane); }
    v[0] = RsStep<NV>::run(v, lane);
}

constexpr int VP = 272;
constexpr int MX_V = 0, MX_VBUF = 34816, MX_STAT = 69632, MX_LN = 70656;
constexpr int XP = 512, AP = 528;
constexpr int MX_X = 0, MX_A = 40960;
__device__ __forceinline__ void ph_mixer_ab(const bf16_t* P, unsigned char* Y, const bf16_t* Wsgu, const float* sgu_b, const float* ln_g, const float* ln_b, const bf16_t* Wpool, const float* pool_scale,
                                            LAS unsigned char* lds, int blk, int nblk, const int tid) {
    const int w = __builtin_amdgcn_readfirstlane(tid >> 6), lane = tid & 63, fr = lane & 15, fq = lane >> 4;
    LAS f32x2* stat = (LAS f32x2*)(lds + MX_STAT);
    LAS float* lng = (LAS float*)(lds + MX_LN); LAS float* lnb = lng + 1024;
    *(LAS f32x2*)(lng + 2 * tid) = *(const f32x2*)(ln_g + 2 * tid); *(LAS f32x2*)(lnb + 2 * tid) = *(const f32x2*)(ln_b + 2 * tid);
    for (int unit = blk; unit < NTOK / 128; unit += nblk) {
        const int tok0 = unit * 128, pos0 = tok0 & (SEQ - 1);
#pragma unroll 1
        for (int i0 = 0; i0 < 16; i0 += 8) {
            float sv[16];
#pragma unroll
            for (int i = 0; i < 8; ++i) { const u32x4* vr = (const u32x4*)(P + (size_t)(tok0 + w * 16 + i0 + i) * 3072 + 1024);
                float sa = 0.f, qa = 0.f;
#pragma unroll
                for (int j = 0; j < 2; ++j) { const u32x4 x = vr[lane + 64 * j];
#pragma unroll
                    for (int e = 0; e < 4; ++e) { const float a = bf_lo(x[e]), b = bf_hi(x[e]); sa += a + b; qa += a * a + b * b; } }
                sv[2 * i] = sa; sv[2 * i + 1] = qa; }
            reduce_scatter<16>(sv, lane);
            const float other = shfl_xor_l(sv[0], 1, lane);
            if ((lane & 1) == 0 && lane < 16) { const float mean = sv[0] * (1.0f / 1024.0f), var = fmaxf(other * (1.0f / 1024.0f) - mean * mean, 0.f);
                stat[w * 16 + i0 + (lane >> 1)] = (f32x2){mean, __builtin_amdgcn_rsqf(var + EPS)}; }
        }
        __syncthreads();
        u32x4 vn[4];
#pragma unroll
        for (int j = 0; j < 4; ++j) { const int q = tid + 512 * j, t = q >> 4, c8 = q & 15; vn[j] = *(const u32x4*)(P + (size_t)(tok0 + t) * 3072 + 1024 + c8 * 8); }
        bf16x8 wsn[4]; u32x2 un[8]; float bn;
        { const int t = 16 * w + fr;
#pragma unroll
          for (int ks = 0; ks < 4; ++ks) wsn[ks] = *(const bf16x8*)(Wsgu + ((size_t)(16 * w + fr)) * 128 + 32 * ks + 8 * fq);
          bn = sgu_b[t];
#pragma unroll
          for (int c = 0; c < 8; ++c) un[c] = *(const u32x2*)(P + (size_t)(tok0 + t) * 3072 + 4 * fq + 16 * c); }
#pragma unroll 1
        for (int h = 0; h < 8; ++h) {
            LAS unsigned char* vb = lds + MX_V + (h & 1) * MX_VBUF;
#pragma unroll
            for (int j = 0; j < 4; ++j) { const int q = tid + 512 * j, t = q >> 4, c8 = q & 15;
                const f32x2 st = stat[t];
                const f32x4 g0 = *(const LAS f32x4*)(lng + h * 128 + c8 * 8), g1 = *(const LAS f32x4*)(lng + h * 128 + c8 * 8 + 4);
                const f32x4 b0 = *(const LAS f32x4*)(lnb + h * 128 + c8 * 8), b1 = *(const LAS f32x4*)(lnb + h * 128 + c8 * 8 + 4);
                float r[8];
#pragma unroll
                for (int e = 0; e < 4; ++e) { r[2 * e] = bf_lo(vn[j][e]); r[2 * e + 1] = bf_hi(vn[j][e]); }
#pragma unroll
                for (int e = 0; e < 4; ++e) { r[e] = (r[e] - st.x) * st.y * g0[e] + b0[e]; r[4 + e] = (r[4 + e] - st.x) * st.y * g1[e] + b1[e]; }
                u32x4 o; o.x = cvt_pk_bf16(r[0], r[1]); o.y = cvt_pk_bf16(r[2], r[3]); o.z = cvt_pk_bf16(r[4], r[5]); o.w = cvt_pk_bf16(r[6], r[7]);
                *(LAS u32x4*)(vb + t * VP + c8 * 16) = o; }
            __syncthreads();
            if (h < 7) {
#pragma unroll
                for (int j = 0; j < 4; ++j) { const int q = tid + 512 * j, t = q >> 4, c8 = q & 15; vn[j] = *(const u32x4*)(P + (size_t)(tok0 + t) * 3072 + 1024 + (h + 1) * 128 + c8 * 8); } }
            bf16x8 wsf[4]; u32x2 uv[8];
#pragma unroll
            for (int ks = 0; ks < 4; ++ks) wsf[ks] = wsn[ks];
#pragma unroll
            for (int c = 0; c < 8; ++c) uv[c] = un[c];
            const int t = 16 * w + fr; const float bias = bn;
            unsigned char* yp = Y + (size_t)(tok0 + t) * DM + h * 128 + 4 * fq;
            if (h < 7) {
#pragma unroll
                for (int ks = 0; ks < 4; ++ks) wsn[ks] = *(const bf16x8*)(Wsgu + ((size_t)((h + 1) * 128 + 16 * w + fr)) * 128 + 32 * ks + 8 * fq);
                bn = sgu_b[(h + 1) * 128 + t];
#pragma unroll
                for (int c = 0; c < 8; ++c) un[c] = *(const u32x2*)(P + (size_t)(tok0 + t) * 3072 + (h + 1) * 128 + 4 * fq + 16 * c); }
            f32x4 acc[8];
#pragma unroll
            for (int c = 0; c < 8; ++c) acc[c] = (f32x4){0.f, 0.f, 0.f, 0.f};
            const int q4 = fr >> 2, p4 = fr & 3;
#pragma unroll
            for (int c = 0; c < 8; ++c)
#pragma unroll
                for (int ks = 0; ks < 4; ++ks) {
                    const LAS unsigned char* a0 = vb + (32 * ks + 8 * fq + q4) * VP + (16 * c + 4 * p4) * 2;
                    const bf16x4 lo = __builtin_amdgcn_ds_read_tr16_b64_v4i16((LAS bf16x4*)a0);
                    const bf16x4 hi = __builtin_amdgcn_ds_read_tr16_b64_v4i16((LAS bf16x4*)(a0 + 4 * VP));
                    const bf16x8 vf = __builtin_shufflevector(lo, hi, 0, 1, 2, 3, 4, 5, 6, 7);
                    acc[c] = __builtin_amdgcn_mfma_f32_16x16x32_bf16(vf, wsf[ks], acc[c], 0, 0, 0);
                }
#pragma unroll
            for (int c = 0; c < 8; ++c) { const u32x2 u = uv[c];
                *(unsigned*)(yp + 16 * c) = pg8::pk4_fp8c(bf_lo(u.x) * (acc[c][0] + bias), bf_hi(u.x) * (acc[c][1] + bias), bf_lo(u.y) * (acc[c][2] + bias), bf_hi(u.y) * (acc[c][3] + bias)); }
        }
        __syncthreads();
        { const int co = tid & 127, tq = tid >> 7, win = 2 << (co >> 5), pos = pos0 + tq * 32;
          const bf16_t* qp = P + (size_t)(tok0 + tq * 32) * 3072 + 2048 + co * 8; unsigned char* yp = Y + (size_t)(tok0 + tq * 32) * DM + 1024 + co * 8;
          float run[8];
#pragma unroll
          for (int e = 0; e < 8; ++e) run[e] = 0.f;
          { u32x4 xi[15];
#pragma unroll
            for (int d = 1; d < 16; ++d) { const bool ok = (d < win) && (pos - d >= 0); const u32x4 x = *(const u32x4*)(qp - (size_t)(ok ? d : 0) * 3072); xi[d - 1] = ok ? x : (u32x4){0u, 0u, 0u, 0u}; }
#pragma unroll
            for (int d = 0; d < 15; ++d)
#pragma unroll
                for (int e = 0; e < 4; ++e) { run[2 * e] += bf_lo(xi[d][e]); run[2 * e + 1] += bf_hi(xi[d][e]); } }
#pragma unroll 1
          for (int tb = 0; tb < 32; tb += 8) {
              u32x4 xin[8], xout[8];
#pragma unroll
              for (int k = 0; k < 8; ++k) { xin[k] = *(const u32x4*)(qp + (size_t)(tb + k) * 3072);
                  const int lo = tb + k + 1 - win; const bool ok = pos + lo >= 0; const u32x4 y = *(const u32x4*)(qp + (long)(ok ? lo : 0) * 3072); xout[k] = ok ? y : (u32x4){0u, 0u, 0u, 0u}; }
#pragma unroll
              for (int k = 0; k < 8; ++k) { float xv[8], r[8];
#pragma unroll
                  for (int e = 0; e < 4; ++e) { xv[2 * e] = bf_lo(xin[k][e]); xv[2 * e + 1] = bf_hi(xin[k][e]); }
                  const int pk = pos + tb + k; const float inv = 1.0f / (float)((pk + 1) < win ? (pk + 1) : win);
#pragma unroll
                  for (int e = 0; e < 8; ++e) { run[e] += xv[e]; r[e] = run[e] * inv - xv[e]; }
                  u32x2 o; o.x = pg8::pk4_fp8c(r[0], r[1], r[2], r[3]); o.y = pg8::pk4_fp8c(r[4], r[5], r[6], r[7]);
                  *(u32x2*)(yp + (size_t)(tb + k) * DM) = o;
#pragma unroll
                  for (int e = 0; e < 4; ++e) { run[2 * e] -= bf_lo(xout[k][e]); run[2 * e + 1] -= bf_hi(xout[k][e]); } } } }
        __syncthreads();
    }
}

constexpr int CD_T = 32, CD_H = 30, CD_ROWS = CD_T + CD_H;
constexpr int CD_RED = (CD_ROWS + 1) * 2048, CD_STAT = MISC_OFF + 1024;
__device__ __forceinline__ void ph_mixer_cd(const bf16_t* P, unsigned char* Y, const float* c3w, const float* c3b, const float* c31w, const float* c31b, const float* ln_g, const float* ln_b,
                                            LAS unsigned char* lds, int blk, int nblk, const int tid) {
    const int w = __builtin_amdgcn_readfirstlane(tid >> 6), lane = tid & 63;
    LAS float* red = (LAS float*)(lds + CD_RED); LAS f32x2* stat = (LAS f32x2*)(lds + CD_STAT);
    const int c0 = 2 * tid;
    for (int unit = blk; unit < NTOK / CD_T; unit += nblk) {
        const int tok0 = unit * CD_T, pos0 = tok0 & (SEQ - 1);
#pragma unroll 1
        for (int jb = 0; jb < 16; jb += 8) {
            u32x4 av[8];
#pragma unroll
            for (int j = 0; j < 8; ++j) { const int q = tid + 512 * (jb + j), r = q >> 7, c8 = q & 127; const bool ok = (r < CD_ROWS) && (pos0 - CD_H + r >= 0);
                av[j] = *(const u32x4*)(P + (size_t)(tok0 + (ok ? r - CD_H : 0)) * 3072 + 2048 + c8 * 8); }
#pragma unroll
            for (int j = 0; j < 8; ++j) { const int q = tid + 512 * (jb + j), r = q >> 7, c8 = q & 127; const bool ok = (r < CD_ROWS) && (pos0 - CD_H + r >= 0);
                if (r <= CD_ROWS) *(LAS u32x4*)(lds + r * 2048 + c8 * 16) = ok ? av[j] : (u32x4){0u, 0u, 0u, 0u}; }
        }
        __syncthreads();
        f32x2 acc[CD_T];
        { const f32x2 bb = *(const f32x2*)(c31b + c0);
#pragma unroll
          for (int t = 0; t < CD_T; ++t) acc[t] = bb; }
        f32x2 wkn[4];
#pragma unroll
        for (int k = 0; k < 4; ++k) wkn[k] = *(const f32x2*)(c31w + k * 1024 + c0);
#pragma unroll 1
        for (int kb = 0; kb < 8; ++kb) {
            f32x2 wk[4];
#pragma unroll
            for (int k = 0; k < 4; ++k) wk[k] = wkn[k];
            if (kb < 7) {
#pragma unroll
                for (int k = 0; k < 4; ++k) { const int kk = 4 * (kb + 1) + k; wkn[k] = (f32x2){0.f, 0.f}; if (kk < 31) wkn[k] = *(const f32x2*)(c31w + kk * 1024 + c0); } }
            f32x2 dv[CD_T + 3];
#pragma unroll
            for (int i = 0; i < CD_T + 3; ++i) { const unsigned d = *(const LAS unsigned*)(lds + (4 * kb + i) * 2048 + tid * 4); dv[i] = (f32x2){bf_lo(d), bf_hi(d)}; }
#pragma unroll
            for (int k = 0; k < 4; ++k)
#pragma unroll
                for (int t = 0; t < CD_T; ++t) acc[t] += wk[k] * dv[t + k];
        }
        { float sv[64];
#pragma unroll
          for (int t = 0; t < CD_T; ++t) { sv[2 * t] = acc[t].x + acc[t].y; sv[2 * t + 1] = acc[t].x * acc[t].x + acc[t].y * acc[t].y; }
          reduce_scatter<64>(sv, lane);
          red[w * 64 + lane] = sv[0]; }
        __syncthreads();
        if (tid < CD_T) { float sa = 0.f, qa = 0.f;
#pragma unroll
            for (int ww = 0; ww < 8; ++ww) { sa += red[ww * 64 + 2 * tid]; qa += red[ww * 64 + 2 * tid + 1]; }
            const float mean = sa * (1.0f / 1024.0f), var = fmaxf(qa * (1.0f / 1024.0f) - mean * mean, 0.f);
            stat[tid] = (f32x2){mean, __builtin_amdgcn_rsqf(var + EPS)}; }
        __syncthreads();
        { const f32x2 gg = *(const f32x2*)(ln_g + c0), bb = *(const f32x2*)(ln_b + c0);
#pragma unroll
          for (int t = 0; t < CD_T; ++t) { const f32x2 st = stat[t];
              const float a = (acc[t].x - st.x) * st.y * gg.x + bb.x, b = (acc[t].y - st.x) * st.y * gg.y + bb.y;
              *(unsigned short*)(Y + (size_t)(tok0 + t) * DM + 1024 + c0) = (unsigned short)__builtin_amdgcn_cvt_pk_fp8_f32(pg8::clamp8(fast_silu(a) * pg8::Y8M_SCALE), pg8::clamp8(fast_silu(b) * pg8::Y8M_SCALE), 0, false); } }
        { const int c8 = tid & 127, tg = tid >> 7, cc = c8 * 8, t0 = tg * 8;
          const f32x4 w0a = *(const f32x4*)(c3w + cc), w0b = *(const f32x4*)(c3w + cc + 4), w1a = *(const f32x4*)(c3w + 1024 + cc), w1b = *(const f32x4*)(c3w + 1024 + cc + 4);
          const f32x4 w2a = *(const f32x4*)(c3w + 2048 + cc), w2b = *(const f32x4*)(c3w + 2048 + cc + 4), bba = *(const f32x4*)(c3b + cc), bbb = *(const f32x4*)(c3b + cc + 4);
          float wv0[8], wv1[8], wv2[8], bv[8];
#pragma unroll
          for (int e = 0; e < 4; ++e) { wv0[e] = w0a[e]; wv0[4 + e] = w0b[e]; wv1[e] = w1a[e]; wv1[4 + e] = w1b[e]; wv2[e] = w2a[e]; wv2[4 + e] = w2b[e]; bv[e] = bba[e]; bv[4 + e] = bbb[e]; }
          u32x4 zv[10], bgv[8];
#pragma unroll
          for (int i = 0; i < 10; ++i) { const bool ok = pos0 + t0 + i - 2 >= 0; const u32x4 a = *(const u32x4*)(P + (size_t)(tok0 + (ok ? t0 + i - 2 : 0)) * 3072 + 1024 + cc); zv[i] = ok ? a : (u32x4){0u, 0u, 0u, 0u}; }
#pragma unroll
          for (int i = 0; i < 8; ++i) bgv[i] = *(const u32x4*)(P + (size_t)(tok0 + t0 + i) * 3072 + cc);
          float z0[8], z1[8];
#pragma unroll
          for (int e = 0; e < 4; ++e) { z0[2 * e] = bf_lo(zv[0][e]); z0[2 * e + 1] = bf_hi(zv[0][e]); z1[2 * e] = bf_lo(zv[1][e]); z1[2 * e + 1] = bf_hi(zv[1][e]); }
#pragma unroll
          for (int i = 0; i < 8; ++i) { float z2[8], r[8];
#pragma unroll
              for (int e = 0; e < 4; ++e) { z2[2 * e] = bf_lo(zv[i + 2][e]); z2[2 * e + 1] = bf_hi(zv[i + 2][e]); }
#pragma unroll
              for (int e = 0; e < 4; ++e) { r[2 * e] = bf_lo(bgv[i][e]) * (bv[2 * e] + wv0[2 * e] * z0[2 * e] + wv1[2 * e] * z1[2 * e] + wv2[2 * e] * z2[2 * e]);
                  r[2 * e + 1] = bf_hi(bgv[i][e]) * (bv[2 * e + 1] + wv0[2 * e + 1] * z0[2 * e + 1] + wv1[2 * e + 1] * z1[2 * e + 1] + wv2[2 * e + 1] * z2[2 * e + 1]); }
              u32x2 o; o.x = pg8::pk4_fp8c(r[0], r[1], r[2], r[3]); o.y = pg8::pk4_fp8c(r[4], r[5], r[6], r[7]);
              *(u32x2*)(Y + (size_t)(tok0 + t0 + i) * DM + cc) = o;
#pragma unroll
              for (int e = 0; e < 8; ++e) { z0[e] = z1[e]; z1[e] = z2[e]; } } }
        __syncthreads();
    }
}

__device__ __forceinline__ void ph_route(const float* logits, const float* rbias, unsigned* gcnt, int* ts_e, int* ts_r, float* ts_w, LAS unsigned char* lds, int blk, int nblk, const int tid) {
    const int w = __builtin_amdgcn_readfirstlane(tid >> 6), lane = tid & 63;
    LAS unsigned* lcnt = (LAS unsigned*)lds; LAS unsigned* lbase = lcnt + 64; LAS unsigned* rec = lcnt + 128;
    const float rb = rbias[lane];
    for (int chunk = blk; chunk < NTOK / 128; chunk += nblk) {
        if (tid < 64) lcnt[tid] = 0u;
        __syncthreads();
        for (int i = 0; i < 16; ++i) { const int tl = w * 16 + i, tok = chunk * 128 + tl;
            const float score = 1.0f / (1.0f + __expf(-logits[(size_t)tok * NE + lane])), choice = score + rb;
            float m1 = choice, m2 = -INFINITY;
#pragma unroll
            for (int o = 1; o < 8; o <<= 1) { const float o1 = o == 1 ? dpp_f<0xB1>(m1, m1) : o == 2 ? dpp_f<0x4E>(m1, m1) : dpp_f<0x141>(m1, m1), o2 = o == 1 ? dpp_f<0xB1>(m2, m2) : o == 2 ? dpp_f<0x4E>(m2, m2) : dpp_f<0x141>(m2, m2);
                const float n1 = fmaxf(m1, o1), n2 = fmaxf(fminf(m1, o1), fmaxf(m2, o2)); m1 = n1; m2 = n2; }
            const float gs = m1 + m2; const int myg = lane >> 3; int grank = 0;
#pragma unroll
            for (int g = 0; g < 8; ++g) { const float s = rdlane(gs, g * 8); grank += (s > gs || (s == gs && g < myg)) ? 1 : 0; }
            const unsigned cb = __builtin_bit_cast(unsigned, choice), mono = (cb & 0x80000000u) ? ~cb : (cb | 0x80000000u);
            const unsigned key = grank < 4 ? ((mono & ~63u) | (unsigned)(63 - lane)) : 0u;
            int rank = 0;
#pragma unroll
            for (int j = 0; j < 64; ++j) { const unsigned kj = (unsigned)__builtin_amdgcn_readlane((int)key, j); rank += (kj > key) ? 1 : 0; }
            const bool sel = rank < TOPK;
            const float wsum = wave_sum(sel ? score : 0.f, lane);
            if (sel) { const unsigned lp = atomicAdd((unsigned*)&lcnt[lane], 1u); rec[tl * TOPK + rank] = (unsigned)lane | (lp << 8); ts_w[(size_t)tok * TOPK + rank] = score / wsum * 2.5f; } }
        __syncthreads();
        if (tid < 64) lbase[tid] = atomicAdd(&gcnt[tid], lcnt[tid]);
        __syncthreads();
        for (int q = tid; q < 128 * TOPK; q += 512) { const unsigned r = rec[q]; const int e = r & 255; const size_t ts = (size_t)chunk * 128 * TOPK + q; ts_e[ts] = e; ts_r[ts] = (int)(lbase[e] + (r >> 8)); }
        __syncthreads();
    }
}

__device__ __forceinline__ void ph_router_prep(const float* rw, const float* g2, const float* modf, bf16_t* WRS, float* CBP, int gtid, int ngt, int gw, int ngw, int lane) {
    for (int i = gtid; i < 2 * NB * NE * (DM / 8); i += ngt) {
        const int k0 = (i & 255) * 8, e = (i >> 8) & 63, b = (i >> 14) & 15, l = i >> 18;
        const float* rwp = rw + (size_t)l * DM * NE + (size_t)k0 * NE + e;
        const float* gp = g2 + l * DM + k0; const float* sp = modf + ((size_t)(l * 6 + 4) * NB + b) * DM + k0;
        const f32x4 ga = *(const f32x4*)gp * *(const f32x4*)sp, gb = *(const f32x4*)(gp + 4) * *(const f32x4*)(sp + 4);
        float v[8];
#pragma unroll
        for (int j = 0; j < 8; ++j) v[j] = rwp[(size_t)j * NE] * (j < 4 ? ga[j & 3] : gb[j & 3]);
        u32x4 o; o.x = cvt_pk_bf16(v[0], v[1]); o.y = cvt_pk_bf16(v[2], v[3]); o.z = cvt_pk_bf16(v[4], v[5]); o.w = cvt_pk_bf16(v[6], v[7]);
        *(u32x4*)(WRS + ((size_t)(l * NB + b) * NE + e) * DM + k0) = o;
    }
    for (int t = gw; t < 2 * NB * 8; t += ngw) { const int kq = t & 7, b = (t >> 3) & 15, l = t >> 7;
        const float* rwp = rw + (size_t)l * DM * NE + (size_t)(kq * 256) * NE + lane; const float* hp = modf + ((size_t)(l * 6 + 3) * NB + b) * DM + kq * 256;
        float s = 0.f;
#pragma unroll 8
        for (int k = 0; k < 256; ++k) s += hp[k] * rwp[(size_t)k * NE];
        CBP[(size_t)((l * NB + b) * 8 + kq) * NE + lane] = s; }
}
constexpr int NR_WR = 0, NR_PITCH = 1040;
constexpr int NR_LG = 69632;
constexpr int NR_CNT = 69632 + 32768;
constexpr int NR_RS = 110592;
__device__ __forceinline__ void ph_norm_route(const bf16_t* x, const float* g, const float* sc1p, const float* sh, const bf16_t* WRSl, const float* CBPl, const float* rbias, unsigned* gcnt,
                                              int* rowtok, int* rowdst, float* roww, LAS unsigned char* lds, int blk, int nblk, const int tid, const int mode, unsigned char* H8) {
    const int w = __builtin_amdgcn_readfirstlane(tid >> 6), lane = tid & 63, fr = lane & 15, fq = lane >> 4;
    LAS unsigned* lcnt = (LAS unsigned*)(lds + NR_CNT); LAS unsigned* lbase = lcnt + 64; LAS unsigned* rec = lcnt + 128; LAS float* recw = (LAS float*)(rec + 768);
    LAS float* lg = (LAS float*)(lds + NR_LG + w * 4096);
    LAS float* rs = (LAS float*)(lds + NR_RS) + w * 16; LAS float* cvec = (LAS float*)(lds + NR_RS + 512);
    const float rb = rbias[lane];
    for (int chunk = blk; chunk < NTOK / 128; chunk += nblk) {
        const int bch = (chunk * 128) >> 11;
        if (tid < 64) { lcnt[tid] = 0u; float c = 0.f;
#pragma unroll
            for (int kq = 0; kq < 8; ++kq) c += CBPl[(size_t)(bch * 8 + kq) * NE + tid];
            cvec[tid] = c; }
        const bf16_t* Wr = WRSl + (size_t)bch * NE * DM;
        const int row0 = chunk * 128 + w * 16;
        { const int b = row0 >> 11;
          const f32x4* g4 = (const f32x4*)g + lane; const f32x4* s4 = (const f32x4*)(sc1p + (size_t)b * DM) + lane; const f32x4* h4 = (const f32x4*)(sh + (size_t)b * DM) + lane;
#pragma unroll 1
          for (int i0 = 0; i0 < 16; i0 += 4) {
            u32x2 t[4][8]; float rstd[4];
#pragma unroll
            for (int r = 0; r < 4; ++r) { const u32x2* xr = (const u32x2*)(x + (size_t)(row0 + i0 + r) * DM) + lane;
#pragma unroll
                for (int j = 0; j < 8; ++j) t[r][j] = xr[64 * j]; }
#pragma unroll
            for (int r = 0; r < 4; ++r) { float a = 0.f;
#pragma unroll
                for (int j = 0; j < 8; ++j) { const float v0 = bf_lo(t[r][j].x), v1 = bf_hi(t[r][j].x), v2 = bf_lo(t[r][j].y), v3 = bf_hi(t[r][j].y); a += (v0 * v0 + v1 * v1) + (v2 * v2 + v3 * v3); }
                rstd[r] = __builtin_amdgcn_rsqf(wave_sum(a, lane) * (1.0f / DM) + EPS); if (lane == 0) rs[i0 + r] = rstd[r]; }
#pragma unroll
            for (int j = 0; j < 8; ++j) { const f32x4 gs = g4[64 * j] * s4[64 * j], hh = h4[64 * j];
#pragma unroll
                for (int r = 0; r < 4; ++r) { const f32x4 vv = (f32x4){bf_lo(t[r][j].x), bf_hi(t[r][j].x), bf_lo(t[r][j].y), bf_hi(t[r][j].y)}; const f32x4 o4 = vv * rstd[r] * gs + hh;
                    ((unsigned*)(H8 + (size_t)(row0 + i0 + r) * DM) + lane)[64 * j] = pg8::pk4_fp8(o4[0], o4[1], o4[2], o4[3]); } }
          } }
        if (PROBE_N > 0 && mode == 2) continue;
        f32x4 acc[4];
#pragma unroll
        for (int nt = 0; nt < 4; ++nt) acc[nt] = (f32x4){0.f, 0.f, 0.f, 0.f};
#pragma unroll 1
        for (int kq = 0; kq < 4; ++kq) {
            bf16x8 hf[16];
#pragma unroll
            for (int ks = 0; ks < 16; ++ks) hf[ks] = *(const bf16x8*)(x + (size_t)(row0 + fr) * DM + kq * 512 + 32 * ks + 8 * fq);
            __syncthreads();
#pragma unroll
            for (int j = 0; j < 8; ++j) { const int q = tid + 512 * j, e = q >> 6, c8 = q & 63;
                *(LAS u32x4*)(lds + NR_WR + e * NR_PITCH + c8 * 16) = *(const u32x4*)(Wr + (size_t)e * DM + kq * 512 + c8 * 8); }
            __syncthreads();
#pragma unroll
            for (int ks = 0; ks < 16; ++ks) {
#pragma unroll
                for (int nt = 0; nt < 4; ++nt) { const bf16x8 wf = *(const LAS bf16x8*)(lds + NR_WR + (16 * nt + fr) * NR_PITCH + (32 * ks + 8 * fq) * 2);
                    acc[nt] = __builtin_amdgcn_mfma_f32_16x16x32_bf16(wf, hf[ks], acc[nt], 0, 0, 0); }
            }
        }
        { const float rsv = rs[fr];
#pragma unroll
          for (int nt = 0; nt < 4; ++nt) *(LAS f32x4*)(lg + fr * 64 + 16 * nt + 4 * fq) = acc[nt] * rsv + *(const LAS f32x4*)(cvec + 16 * nt + 4 * fq); }
        LDS_WAIT();
        if (PROBE_N > 0 && mode == 3) continue;
        for (int i = 0; i < 16; ++i) { const int tl = w * 16 + i, tok = chunk * 128 + tl;
            const float score = 1.0f / (1.0f + __expf(-lg[i * 64 + lane])), choice = score + rb;
            float m1 = choice, m2 = -INFINITY;
#pragma unroll
            for (int o = 1; o < 8; o <<= 1) { const float o1 = o == 1 ? dpp_f<0xB1>(m1, m1) : o == 2 ? dpp_f<0x4E>(m1, m1) : dpp_f<0x141>(m1, m1), o2 = o == 1 ? dpp_f<0xB1>(m2, m2) : o == 2 ? dpp_f<0x4E>(m2, m2) : dpp_f<0x141>(m2, m2);
                const float n1 = fmaxf(m1, o1), n2 = fmaxf(fminf(m1, o1), fmaxf(m2, o2)); m1 = n1; m2 = n2; }
            const float gs = m1 + m2; const int myg = lane >> 3; int grank = 0;
#pragma unroll
            for (int gq = 0; gq < 8; ++gq) { const float sv = rdlane(gs, gq * 8); grank += (sv > gs || (sv == gs && gq < myg)) ? 1 : 0; }
            const float masked = grank < 4 ? choice : -INFINITY;
            unsigned long long selm = 0ull; float cur = masked;
#pragma unroll
            for (int r = 0; r < TOPK; ++r) { const float mx = wave_max(cur); const unsigned long long eq = __builtin_amdgcn_ballot_w64(cur == mx); const int idx = __builtin_ctzll(eq);
                selm |= 1ull << idx; cur = (lane == idx) ? -INFINITY : cur; }
            const bool sel = ((selm >> lane) & 1ull) != 0ull;
            const int rank = (int)__builtin_amdgcn_mbcnt_hi((unsigned)(selm >> 32), __builtin_amdgcn_mbcnt_lo((unsigned)selm, 0u));
            const float wsum = wave_sum(sel ? score : 0.f, lane);
            if (sel) { const unsigned lp = atomicAdd((unsigned*)&lcnt[lane], 1u); rec[tl * TOPK + rank] = (unsigned)lane | (lp << 8); recw[tl * TOPK + rank] = score / wsum * 2.5f; } }
        __syncthreads();
        if (tid < 64) lbase[tid] = atomicAdd(&gcnt[tid], lcnt[tid]);
        __syncthreads();
        for (int q = tid; q < 128 * TOPK; q += 512) { const unsigned r = rec[q]; const int e = r & 255; const unsigned pos = lbase[e] + (r >> 8);
            if (pos < (unsigned)ECAP) { const size_t row = (size_t)e * ECAP + pos; rowtok[row] = chunk * 128 + q / TOPK; rowdst[row] = chunk * 128 * TOPK + q; roww[row] = recw[q]; } }
        __syncthreads();
    }
}
template <bool LAST>
__device__ __forceinline__ void ph_combine_norm(const bf16_t* x, void* xo, const unsigned char* Y6, const unsigned char* shout, const float* gate, const float* gn, const float* scn, const float* shn, unsigned char* H8, int gw, int ngw, int lane) {
    for (int row = gw; row < NTOK; row += ngw) {
        const int b = row >> 11;
        const bf16_t* xr = x + (size_t)row * DM; const unsigned char* yr = Y6 + (size_t)row * (TOPK * DM); const unsigned char* sr = shout + (size_t)row * DM; const float* gr = gate + (size_t)b * DM;
        float v[2][16]; float ss = 0.f;
        u32x4 yv[2][TOPK + 1], xv[2][2];
#pragma unroll
        for (int j = 0; j < 2; ++j) { const int c = 16 * (lane + 64 * j);
#pragma unroll
            for (int k = 0; k < TOPK; ++k) yv[j][k] = *(const u32x4*)(yr + (size_t)k * DM + c);
            yv[j][TOPK] = *(const u32x4*)(sr + c); xv[j][0] = *(const u32x4*)(xr + c); xv[j][1] = *(const u32x4*)(xr + c + 8); }
        asm volatile("" ::: "memory");
#pragma unroll
        for (int j = 0; j < 2; ++j) { const int c = 16 * (lane + 64 * j);
            float m[16];
#pragma unroll
            for (int e = 0; e < 16; ++e) m[e] = 0.f;
#pragma unroll
            for (int k = 0; k < TOPK + 1; ++k) { const u32x4 t = yv[j][k];
#pragma unroll
                for (int e = 0; e < 4; ++e) { const f32x2 lo = __builtin_amdgcn_cvt_pk_f32_fp8((int)t[e], false), hi = __builtin_amdgcn_cvt_pk_f32_fp8((int)t[e], true);
                    m[4 * e] += lo.x; m[4 * e + 1] += lo.y; m[4 * e + 2] += hi.x; m[4 * e + 3] += hi.y; } }
#pragma unroll
            for (int e = 0; e < 16; ++e) m[e] *= (1.0f / pg8::Y8_SCALE);
            { const u32x4 x0 = xv[j][0], x1 = xv[j][1]; float xf[16];
#pragma unroll
              for (int e = 0; e < 4; ++e) { xf[2 * e] = bf_lo(x0[e]); xf[2 * e + 1] = bf_hi(x0[e]); xf[8 + 2 * e] = bf_lo(x1[e]); xf[8 + 2 * e + 1] = bf_hi(x1[e]); }
#pragma unroll
              for (int q = 0; q < 4; ++q) { const f32x4 gv = *(const f32x4*)(gr + c + 4 * q);
#pragma unroll
                  for (int e = 0; e < 4; ++e) { v[j][4 * q + e] = xf[4 * q + e] + gv[e] * m[4 * q + e]; ss += v[j][4 * q + e] * v[j][4 * q + e]; } } }
            asm volatile("" : "+v"(v[j][0]), "+v"(v[j][1]), "+v"(v[j][2]), "+v"(v[j][3]), "+v"(v[j][4]), "+v"(v[j][5]), "+v"(v[j][6]), "+v"(v[j][7]),
                              "+v"(v[j][8]), "+v"(v[j][9]), "+v"(v[j][10]), "+v"(v[j][11]), "+v"(v[j][12]), "+v"(v[j][13]), "+v"(v[j][14]), "+v"(v[j][15]), "+v"(ss)); }
        const float rstd = __builtin_amdgcn_rsqf(wave_sum(ss, lane) * (1.0f / DM) + EPS);
#pragma unroll
        for (int j = 0; j < 2; ++j) { const int c = 16 * (lane + 64 * j);
            if constexpr (LAST) {
#pragma unroll
                for (int q = 0; q < 4; ++q) { const f32x4 nq = *(const f32x4*)(gn + c + 4 * q); f32x4 o;
#pragma unroll
                    for (int e = 0; e < 4; ++e) o[e] = v[j][4 * q + e] * rstd * nq[e];
                    *(f32x4*)((float*)xo + (size_t)row * DM + c + 4 * q) = o; }
            } else { u32x4 x0, x1;
                x0.x = cvt_pk_bf16(v[j][0], v[j][1]); x0.y = cvt_pk_bf16(v[j][2], v[j][3]); x0.z = cvt_pk_bf16(v[j][4], v[j][5]); x0.w = cvt_pk_bf16(v[j][6], v[j][7]);
                x1.x = cvt_pk_bf16(v[j][8], v[j][9]); x1.y = cvt_pk_bf16(v[j][10], v[j][11]); x1.z = cvt_pk_bf16(v[j][12], v[j][13]); x1.w = cvt_pk_bf16(v[j][14], v[j][15]);
                *(u32x4*)((bf16_t*)xo + (size_t)row * DM + c) = x0; *(u32x4*)((bf16_t*)xo + (size_t)row * DM + c + 8) = x1; }
            if constexpr (!LAST) { float r[16];
#pragma unroll
                for (int q = 0; q < 4; ++q) { const f32x4 nq = *(const f32x4*)(gn + c + 4 * q), sq = *(const f32x4*)(scn + (size_t)b * DM + c + 4 * q), hq = *(const f32x4*)(shn + (size_t)b * DM + c + 4 * q);
#pragma unroll
                    for (int e = 0; e < 4; ++e) r[4 * q + e] = v[j][4 * q + e] * rstd * nq[e] * sq[e] + hq[e]; }
                u32x4 h0; h0.x = pg8::pk4_fp8(r[0], r[1], r[2], r[3]); h0.y = pg8::pk4_fp8(r[4], r[5], r[6], r[7]); h0.z = pg8::pk4_fp8(r[8], r[9], r[10], r[11]); h0.w = pg8::pk4_fp8(r[12], r[13], r[14], r[15]);
                *(u32x4*)(H8 + (size_t)row * DM + c) = h0; }
            asm volatile("" ::: "memory"); }
    }
}
__device__ __forceinline__ void ph_build(unsigned* gcnt, unsigned* ntiles, const int* ts_e, const int* ts_r, const float* ts_w, int* rowtok, int* rowdst, float* roww, int* tile_e, LAS unsigned char* lds, int blk, int nblk, const int tid) {
    LAS int* cnt = (LAS int*)lds; LAS int* poff = cnt + 64;
    if (tid < 64) cnt[tid] = (int)__hip_atomic_load(gcnt + tid, __ATOMIC_RELAXED, __HIP_MEMORY_SCOPE_AGENT);
    __syncthreads();
    if (tid == 0) { int o = 0; for (int e = 0; e < 64; ++e) { poff[e] = o; o += (cnt[e] + 255) & ~255; } poff[64] = o; }
    __syncthreads();
    if (blk == 0 && tid == 0) __hip_atomic_store(ntiles, (unsigned)(poff[64] >> 8), __ATOMIC_RELAXED, __HIP_MEMORY_SCOPE_AGENT);
    for (size_t ts = (size_t)blk * 512 + tid; ts < (size_t)NSLOT; ts += (size_t)nblk * 512) { const int e = ts_e[ts], row = poff[e] + ts_r[ts]; rowtok[row] = (int)(ts / TOPK); rowdst[row] = (int)ts; roww[row] = ts_w[ts]; }
    for (int e = blk; e < 64; e += nblk) {
        const int p0 = poff[e], c = cnt[e], p1 = poff[e + 1];
        for (int r = p0 + c + tid; r < p1; r += 512) { rowtok[r] = 0; rowdst[r] = -1; roww[r] = 0.f; }
        for (int t = (p0 >> 8) + tid; t < (p1 >> 8); t += 512) tile_e[t] = e;
    }
}

constexpr int NPHASE = 19;
__host__ __device__ constexpr int phid(int k) { return k < 3 ? k : 3 + (k - 3) % 8; }
typedef const __attribute__((address_space(4))) char* kptr_t;
__device__ __forceinline__ kptr_t kargs() { kptr_t p = (kptr_t)__builtin_amdgcn_kernarg_segment_ptr(); asm volatile("" : "+s"(p)); return p; }
__device__ __forceinline__ const float* karg_in(kptr_t kp, int i) { return *(const float* const __attribute__((address_space(4)))*)(kp + 8 * i); }
__device__ __forceinline__ float* karg_out(kptr_t kp) { return *(float* const __attribute__((address_space(4)))*)(kp + 248); }
__device__ __forceinline__ int karg_probe(kptr_t kp) { return *(const __attribute__((address_space(4))) int*)(kp + 272); }
__device__ __forceinline__ unsigned char* karg_ws(kptr_t kp) { return *(unsigned char* const __attribute__((address_space(4)))*)(kp + 256); }
__device__ __forceinline__ int opaque_tid(int wave0) { int t; asm volatile("v_mbcnt_lo_u32_b32 %0, -1, 0\n\tv_mbcnt_hi_u32_b32 %0, -1, %0" : "=v"(t)); return wave0 * 64 + t; }

__device__ __forceinline__ int build_tile_table(const unsigned* gcnt, LAS int* tl, LAS unsigned char* lds, const int tid) {
    LAS int* cnt = (LAS int*)lds; LAS int* pre = cnt + 64;
    if (tid < 64) { const int c = (int)__hip_atomic_load(gcnt + tid, __ATOMIC_RELAXED, __HIP_MEMORY_SCOPE_AGENT); cnt[tid] = c < ECAP ? c : ECAP; }
    __syncthreads();
    if (tid == 0) { int o = 0; for (int e = 0; e < 64; ++e) { pre[e] = o; o += (cnt[e] + 255) >> 8; } pre[64] = o; }
    __syncthreads();
    const int total = pre[64];
    for (int i = tid; i < total; i += 512) { int e = 0;
#pragma unroll 1
        for (int s2 = 32; s2 >= 1; s2 >>= 1) if (pre[e + s2] <= i) e += s2;
        const int t = i - pre[e], nv = cnt[e] - t * 256; tl[i] = (int)(((unsigned)e << 26) | ((unsigned)t << 16) | (unsigned)(nv < 256 ? nv : 256)); }
    __syncthreads();
    return __builtin_amdgcn_readfirstlane(total);
}

#define ONE_LAUNCH (MASK == 0x7FFu)
#define IN(k) (((MASK >> phid(k)) & 1u) != 0u && (ONE_LAUNCH || (lo <= (k) && (k) < hi)))
#define REPS(id) ((((unsigned)REP_MASK >> (id)) & 1u) ? 2 : 1)
#ifndef BAR_REPS
#define BAR_REPS 1
#endif
#define SEAM(k) do { if (ONE_LAUNCH && (k) + 1 < NPHASE && IN(k) && IN((k) + 1)) { xcd_barrier(bar, opaque_tid(wave0)); if (BAR_REPS > 1) xcd_barrier(bar, opaque_tid(wave0)); if (BAR_REPS > 2) xcd_barrier(bar, opaque_tid(wave0)); } } while (0)
#define PHASE_VIEW() kptr_t kp = kargs(); unsigned char* ws = karg_ws(kp); (void)ws; const int tid = opaque_tid(wave0), lane = tid & 63, wave = __builtin_amdgcn_readfirstlane(tid >> 6); \
        int blk_ = blockIdx.x, G_ = gridDim.x; LAS unsigned char* lds = lds0; asm volatile("" : "+s"(blk_), "+s"(G_), "+s"(lds)); const int blk = blk_, G = G_; \
        const int gw = blk * 8 + wave, ngw = G * 8, gtid = blk * 512 + tid, ngt = G * 512; (void)lane; (void)gw; (void)ngw; (void)gtid; (void)ngt


template <int l, unsigned MASK> __device__ __forceinline__ void layer_body(const int lo, const int hi, const XcdBarrier& bar, const int wave0, LAS unsigned char* const lds0) {
        const int pb = 3 + 8 * l;
#define MF(j) ((const float*)(ws + WS_MODF) + ((size_t)l * 6 + (j)) * NB * DM)
#define CV_CALL(L, FIRST, STRIDE, LO, HI) conv_range(karg_in(kp, I_EW1), karg_in(kp, I_EW3), karg_in(kp, I_EW2), L, ws + WS_WE13, ws + ((L) == 0 ? WS_WE2 : WS_WE2B), (LAS float*)(lds + wave * 16384), FIRST, STRIDE, LO, HI, lane)
#define CV_HOST(ON, NCV, L, LO, HI) const int Gg = G - ((ON) ? (NCV) : 0); if ((ON) && blk >= Gg) { if (!(PROBE_N > 0 && karg_probe(kp) == 9)) CV_CALL(L, (blk - Gg) * 8 + wave, (NCV) * 8, LO, HI); continue; } if (PROBE_N > 0 && karg_probe(kp) == 10) continue;
        if (IN(pb + 0)) for (int rep_ = 0; rep_ < REPS(phid(pb + 0)); ++rep_) { if (rep_) __syncthreads(); PHASE_VIEW();
            const int N = l == 0 ? 3072 : 5120;
            const int ncv_ = l == 0 ? NCV_IN : NCV_IN1, clo_ = l == 0 ? CVQ_P0 : CVQ_C, chi_ = l == 0 ? CVQ_A1 : CV_N13;
            CV_HOST(true, ncv_, l, clo_, chi_)
            pg8::StaticOrder S; S.init(ws + WS_H8, ws + (l == 0 ? WS_WABIN : WS_WCDIN), DM, NTOK, N, Gg, blk, 1);
            if (l == 0) { pg8::EpiBf16 E{(bf16_t*)(ws + WS_P), N, 1.0f / W8_SCALE}; pg8::gemm_phase<pg8::EpiBf16, pg8::StaticOrder, DM, false, 1, true>(lds, S, E, tid); }
            else { pg8::EpiCdIn E{(bf16_t*)(ws + WS_P), 1.0f / W8_SCALE}; pg8::gemm_phase<pg8::EpiCdIn, pg8::StaticOrder, DM, false, 1, true>(lds, S, E, tid); }
        }
        SEAM(pb + 0);
        if (IN(pb + 1)) for (int rep_ = 0; rep_ < REPS(phid(pb + 1)); ++rep_) { if (rep_) __syncthreads(); PHASE_VIEW();
            if (l == 0) ph_mixer_ab((const bf16_t*)(ws + WS_P), ws + WS_Y, (const bf16_t*)(ws + WS_WSGU), karg_in(kp, I_SGUB), karg_in(kp, I_SGULNG), karg_in(kp, I_SGULNB), (const bf16_t*)(ws + WS_WPOOL), karg_in(kp, I_POOLSC), lds, blk, G, tid);
            else ph_mixer_cd((const bf16_t*)(ws + WS_P), ws + WS_Y, karg_in(kp, I_C3W), karg_in(kp, I_C3B), karg_in(kp, I_C31W), karg_in(kp, I_C31B), karg_in(kp, I_CDLNG), karg_in(kp, I_CDLNB), lds, blk, G, tid);
        }
        SEAM(pb + 1);
        if (IN(pb + 2)) for (int rep_ = 0; rep_ < REPS(phid(pb + 2)); ++rep_) { if (rep_) __syncthreads(); PHASE_VIEW();
            CV_HOST(l == 0, NCV_OUT, 0, CVQ_A1, CV_TOT)
            pg8::StaticOrder S; S.init(ws + WS_Y, ws + (l == 0 ? WS_WABOUT : WS_WCDOUT), DM, NTOK, DM, Gg, blk, 1);
            const float oscl = 1.0f / (pg8::Y8M_SCALE * W8_SCALE);
            bf16_t* outp = ((REPS(phid(pb + 2)) == 2 && rep_ == 0) || (PROBE_N > 0 && karg_probe(kp))) ? (bf16_t*)(ws + WS_P) : (bf16_t*)(ws + WS_XB);
            if (l == 0) { pg8::EpiResGate<true> E{karg_in(kp, I_X), outp, MF(2), PROBE_N > 0 ? karg_probe(kp) : 0, oscl}; pg8::gemm_phase<pg8::EpiResGate<true>, pg8::StaticOrder, DM, false, 1, true>(lds, S, E, tid); }
            else { pg8::EpiResGate<false> E{(const void*)(ws + WS_XB), outp, MF(2), PROBE_N > 0 ? karg_probe(kp) : 0, oscl}; pg8::gemm_phase<pg8::EpiResGate<false>, pg8::StaticOrder, DM, false, 1, true>(lds, S, E, tid); }
        }
        SEAM(pb + 2);
        if (IN(pb + 3)) { PHASE_VIEW();
            ph_norm_route((const bf16_t*)(ws + WS_XB), karg_in(kp, I_NFFNG) + l * DM, MF(4), MF(3), (const bf16_t*)(ws + WS_WRS) + (size_t)l * NB * NE * DM, (const float*)(ws + WS_CBP) + (size_t)l * NB * 8 * NE, karg_in(kp, I_RB) + l * NE,
                          (unsigned*)(ws + WS_CTL) + CW_GCNT + l * 64 + ((PROBE_N > 0 && karg_probe(kp)) ? 512 : 0), (int*)(ws + RT_ROWTOK), (int*)(ws + RT_ROWDST), (float*)(ws + RT_ROWW), lds, blk, G, tid, PROBE_N > 0 ? karg_probe(kp) : 0, (unsigned char*)(ws + WS_H8)); }
        SEAM(pb + 3);
        if (IN(pb + 5)) for (int rep_ = 0; rep_ < REPS(phid(pb + 5)); ++rep_) { if (rep_) __syncthreads(); PHASE_VIEW();
            CV_HOST(l == 0, NCV_E1, 1, CV_N13, CV_TOT)
            LAS int* tl = (LAS int*)(lds + SIDE_TILEE);
            const int mt = build_tile_table((const unsigned*)(ws + WS_CTL) + CW_GCNT + l * 64, tl, lds, tid);
            { typedef pg8::ExpertOrder<256 * DM, 768 * DM, 3, true> EO1;
              EO1 S{(const char*)(ws + WS_H8), (const char*)(ws + WS_WE13), tl, (const int*)(ws + RT_ROWTOK), (const int*)(ws + RT_ROWTOK), mt * 3, Gg, blk};
              pg8::EpiSiluMul8 E{(unsigned char*)(ws + WS_ACT), 512, 1.0f / W8_SCALE, -1, 0};
              pg8::gemm_phase<pg8::EpiSiluMul8, EO1, DM, true, 1>(lds, S, E, tid); }
            { PHASE_VIEW();
              const int sh_ = ((((mt * 3) % Gg) + 7) & ~7) % Gg, c2_ = (blk - sh_ + Gg) % Gg;
              pg8::StaticOrder S; S.init(ws + WS_H8, ws + WS_WSH1F8 + (size_t)l * 1024 * DM, DM, NTOK, 1024, Gg, c2_, 1);
              pg8::EpiSiluMul8 E{(unsigned char*)(ws + WS_SACT), SFF, 1.0f / W8_SCALE, -1, 0};
              pg8::gemm_phase<pg8::EpiSiluMul8, pg8::StaticOrder, DM, false, 1>(lds, S, E, tid); }
        }
        SEAM(pb + 5);
        if (IN(pb + 6)) for (int rep_ = 0; rep_ < REPS(phid(pb + 6)); ++rep_) { if (rep_) __syncthreads(); PHASE_VIEW();
            const int Gg = G;
            LAS int* tl = (LAS int*)(lds + SIDE_TILEE);
            const int mt = build_tile_table((const unsigned*)(ws + WS_CTL) + CW_GCNT + l * 64, tl, lds, tid);
            { typedef pg8::ExpertOrder<256 * 512, DM * 512, 8, false> EO2;
              EO2 S{(const char*)(ws + WS_ACT), (const char*)(ws + (l == 0 ? WS_WE2 : WS_WE2B)), tl, (const int*)(ws + RT_ROWDST), (const int*)(ws + RT_ROWW), mt * 8, Gg, blk};
              pg8::EpiScatterY E{(unsigned char*)(ws + WS_YBUF), pg8::Y8_SCALE / (pg8::A8_SCALE * W8_SCALE), PROBE_N > 0 ? karg_probe(kp) : 0};
              pg8::gemm_phase<pg8::EpiScatterY, EO2, 512, false, 1, true, 0, 0, true>(lds, S, E, tid); }
            { PHASE_VIEW();
              const int sh_ = ((((mt * 8) % Gg) + 7) & ~7) % Gg, c2_ = (blk - sh_ + Gg) % Gg;
              pg8::StaticOrder S; S.init(ws + WS_SACT, ws + WS_WSH2F8 + (size_t)l * DM * SFF, SFF, NTOK, DM, Gg, c2_, 1);
              pg8::EpiFp8 E{(unsigned char*)(ws + WS_SHOUT), DM, pg8::Y8_SCALE / (pg8::A8_SCALE * W8_SCALE)};
              pg8::gemm_phase<pg8::EpiFp8, pg8::StaticOrder, SFF, false, 1, true>(lds, S, E, tid); }
        }
        SEAM(pb + 6);
        if (IN(pb + 7)) { PHASE_VIEW();
            if (l == 0) {
                ph_combine_norm<false>((const bf16_t*)(ws + WS_XB), (void*)(ws + WS_XB), (const unsigned char*)(ws + WS_YBUF), (const unsigned char*)(ws + WS_SHOUT), MF(5), karg_in(kp, I_NMIXG) + DM,
                                       (const float*)(ws + WS_MODF) + (size_t)(6 + 1) * NB * DM, (const float*)(ws + WS_MODF) + (size_t)(6 + 0) * NB * DM, (unsigned char*)(ws + WS_H8), gw, ngw, lane);
                CV_CALL(1, gw, ngw, 0, CVQ_C);
            } else {
                ph_combine_norm<true>((const bf16_t*)(ws + WS_XB), (PROBE_N > 0 && karg_probe(kp)) ? (void*)(ws + WS_WE13) : (void*)karg_out(kp), (const unsigned char*)(ws + WS_YBUF), (const unsigned char*)(ws + WS_SHOUT), MF(5), karg_in(kp, I_FG), nullptr, nullptr, nullptr, gw, ngw, lane);
            }
        }
        SEAM(pb + 7);
}

template <unsigned MASK> __global__ void __launch_bounds__(512, 2) mk_fwd(Args) {
    extern __shared__ __attribute__((aligned(16))) unsigned char lds_raw[];
    LAS unsigned char* lds0 = (LAS unsigned char*)lds_raw;
    volatile LAS unsigned* MISC = (volatile LAS unsigned*)(lds0 + MISC_OFF);
    int lo, hi;
    const int wave0 = __builtin_amdgcn_readfirstlane((int)threadIdx.x >> 6);
    XcdBarrier bar;
    { kptr_t kp = kargs(); lo = *(const __attribute__((address_space(4))) int*)(kp + 264); hi = *(const __attribute__((address_space(4))) int*)(kp + 268);
      unsigned* ctl = (unsigned*)(karg_ws(kp) + WS_CTL);
      const int t0 = opaque_tid(wave0);
      if (t0 < 64) MISC[t0] = 0u;
      __syncthreads();
      bar.bar = ctl + CW_BAR; bar.x = 0; bar.st = nullptr;
      if (ONE_LAUNCH) bar = xcd_barrier_post(ctl + CW_BAR, MISC + 8, t0); }
    if (IN(0)) for (int rep_ = 0; rep_ < REPS(phid(0)); ++rep_) { if (rep_) __syncthreads(); PHASE_VIEW();
        if (PROBE_N > 0 && karg_probe(kp) >= 7) {
            const int nb_ = karg_probe(kp) == 7 ? 32 : G;
            if (blk < nb_) conv_range(karg_in(kp, I_EW1), karg_in(kp, I_EW3), karg_in(kp, I_EW2), 0, ws + WS_WE13, ws + WS_WE2, (LAS float*)(lds + wave * 16384), gw, nb_ * 8, 0, CV_TOT, lane);
            continue; }
        ph_mod_partial(karg_in(kp, I_C), karg_in(kp, I_ADAW), (float*)(ws + WS_MODP), lds, blk, G, tid);
        ph_fold_pool(karg_in(kp, I_ABWIN), karg_in(kp, I_POOLW), karg_in(kp, I_POOLSC), ws + WS_WABIN, lds, blk, G, tid);
        ph_convert_misc(kp, ws, (LAS float*)(lds + wave * 16384), gw, ngw, lane, gtid, ngt);
        conv_range(karg_in(kp, I_EW1), karg_in(kp, I_EW3), karg_in(kp, I_EW2), 0, ws + WS_WE13, ws + WS_WE2, (LAS float*)(lds + wave * 16384), gw, ngw, 0, CVQ_P0, lane);
    }
    SEAM(0);
    if (IN(1)) for (int rep_ = 0; rep_ < REPS(phid(1)); ++rep_) { if (rep_) __syncthreads(); PHASE_VIEW(); ph_mod_final((const float*)(ws + WS_MODP), karg_in(kp, I_ADAB), (float*)(ws + WS_MODF), gtid, ngt); }
    SEAM(1);

    if (IN(2)) for (int rep_ = 0; rep_ < REPS(phid(2)); ++rep_) { if (rep_) __syncthreads(); PHASE_VIEW();
        ph_norm(karg_in(kp, I_X), karg_in(kp, I_NMIXG), (const float*)(ws + WS_MODF) + 1 * NB * DM, (const float*)(ws + WS_MODF) + 0 * NB * DM, (unsigned char*)(ws + WS_H8), gw, ngw, lane);
        ph_router_prep(karg_in(kp, I_RW), karg_in(kp, I_NFFNG), (const float*)(ws + WS_MODF), (bf16_t*)(ws + WS_WRS), (float*)(ws + WS_CBP), gtid, ngt, gw, ngw, lane); }
    SEAM(2);

    layer_body<0, MASK>(lo, hi, bar, wave0, lds0);
    layer_body<1, MASK>(lo, hi, bar, wave0, lds0);
#undef IN
#undef SEAM
#undef MF
#undef CV_CALL
#undef CV_HOST
#undef PHASE_VIEW
}

typedef void (*KernFn)(Args);
#if N_LAUNCH_MODE == 1 || PROBE_N > 0
static KernFn kern_of_phase(int id) {
    switch (id) {
        case 0: return mk_fwd<1u << 0>; case 1: return mk_fwd<1u << 1>; case 2: return mk_fwd<1u << 2>; case 3: return mk_fwd<1u << 3>; case 4: return mk_fwd<1u << 4>;
        case 5: return mk_fwd<1u << 5>; case 6: return mk_fwd<1u << 6>; case 7: return mk_fwd<1u << 7>; case 8: return mk_fwd<1u << 8>; case 9: return mk_fwd<1u << 9>;
        default: return mk_fwd<1u << 10>;
    }
}
#endif
#if N_LAUNCH_MODE == 0
static KernFn kern_of(int) { return mk_fwd<0x7FFu>; }
constexpr int NKERN = 1;
#else
static KernFn kern_of(int id) { return kern_of_phase(id); }
constexpr int NKERN = 11;
#endif
extern "C" void kernel_launch(void* const* d_in, const int* in_sizes, int n_in, void* d_out, int out_size, void* d_ws, size_t ws_size, hipStream_t stream) {
    static int grid = 0;
    if (grid == 0) {
        if (n_in != 31 || out_size != NTOK * DM || ws_size < WS_END + (REP_MASK ? 256 * MiB : 0)) { fprintf(stderr, "kernel_launch: unexpected shapes/workspace (n_in %d, out %d, ws %zu < %zu)\n", n_in, out_size, ws_size, (size_t)WS_END); grid = -1; return; }
        int dev = 0, cus = 0, per_cu = 0;
        if (hipGetDevice(&dev) != hipSuccess || hipDeviceGetAttribute(&cus, hipDeviceAttributeMultiprocessorCount, dev) != hipSuccess) { grid = -1; return; }
#if PROBE_N > 0
        for (int i = 0; i < 11; ++i) (void)hipFuncSetAttribute((const void*)kern_of_phase(i), hipFuncAttributeMaxDynamicSharedMemorySize, LDS_BYTES);
#endif
        for (int i = 0; i < NKERN; ++i)
            if (hipFuncSetAttribute((const void*)kern_of(i), hipFuncAttributeMaxDynamicSharedMemorySize, LDS_BYTES) != hipSuccess) { fprintf(stderr, "kernel_launch: hipFuncSetAttribute failed\n"); grid = -1; return; }
        if (hipOccupancyMaxActiveBlocksPerMultiprocessor(&per_cu, (const void*)kern_of(0), 512, LDS_BYTES) != hipSuccess || per_cu < 1) fprintf(stderr, "kernel_launch: occupancy query says %d\n", per_cu);
        (void)hipGetLastError();
        grid = cus;
    }
    if (grid < 0) return;
    (void)hipMemsetAsync((char*)d_ws + WS_CTL, 0, CTL_BYTES, stream);
    Args a{};
    for (int i = 0; i < 31; ++i) a.in[i] = (const float*)d_in[i];
    a.out = (float*)d_out; a.ws = (unsigned char*)d_ws;
    if (N_LAUNCH_MODE == 0) {
        a.ph_lo = 0; a.ph_hi = NPHASE;
        hipLaunchKernelGGL(kern_of(0), dim3(grid), dim3(512), LDS_BYTES, stream, a);
    } else {
        for (int p = 0; p < NPHASE; ++p) { a.ph_lo = p; a.ph_hi = p + 1; hipLaunchKernelGGL(kern_of(phid(p)), dim3(grid), dim3(512), LDS_BYTES, stream, a); }
    }
#if PROBE_N > 0
    { const int plist[] = PROBE_LIST; const int pflag[] = PROBE_FLAG;
      for (int i = 0; i < PROBE_N; ++i) { a.probe = pflag[i]; a.ph_lo = plist[i]; a.ph_hi = plist[i] + 1; hipLaunchKernelGGL(kern_of_phase(phid(plist[i])), dim3(grid), dim3(512), LDS_BYTES, stream, a); } }
#endif
}
```

```cpp
#include <hip/hip_runtime.h>
#include <cstdio>
#include <cstdint>

#ifndef REP_MASK
#define REP_MASK 0u
#endif
#ifndef PROBE_N
#define PROBE_N 0
#define PROBE_LIST {0}
#define PROBE_FLAG {1}
#endif
#ifndef N_LAUNCH_MODE
#define N_LAUNCH_MODE 0
#endif

#define LAS __attribute__((address_space(3)))
typedef unsigned short bf16_t;
typedef short bf16x8 __attribute__((ext_vector_type(8)));
typedef short bf16x4 __attribute__((ext_vector_type(4)));
typedef float f32x4 __attribute__((ext_vector_type(4)));
typedef float f32x2 __attribute__((ext_vector_type(2)));
typedef unsigned u32x4 __attribute__((ext_vector_type(4)));
typedef unsigned u32x2 __attribute__((ext_vector_type(2)));
typedef int i32x4 __attribute__((ext_vector_type(4)));

constexpr int DM = 2048, NB = 16, SEQ = 2048, NTOK = NB * SEQ;
constexpr int NE = 64, TOPK = 6, EFF = 384, SFF = 512;
constexpr int NSLOT = NTOK * TOPK;
constexpr int ECAP = NTOK;
constexpr int MAXROWS = NE * ECAP;
constexpr int MAXTILES = NSLOT / 256 + NE;
constexpr float EPS = 1e-6f;

constexpr size_t MiB = 1u << 20;
constexpr size_t WS_CTL = 0, CTL_BYTES = 1 * MiB;
constexpr size_t WS_MODP = 1 * MiB;
constexpr size_t WS_MODF = 7 * MiB;
constexpr int HP = 2112;
constexpr size_t WS_WSH1 = 57 * MiB;
constexpr size_t WS_WSH2 = 67 * MiB;
constexpr size_t WS_WSGU = 71 * MiB;
constexpr size_t WS_WPOOL = 71 * MiB + 512 * 1024;
constexpr size_t WS_WE13 = 72 * MiB;
constexpr size_t WS_WE2 = 264 * MiB;
constexpr size_t WS_H = 360 * MiB;
constexpr size_t WS_WRS = WS_H, WS_CBP = WS_H + 8 * MiB;
constexpr size_t WS_WE2B = WS_H + 16 * MiB;
constexpr size_t WS_SACT = 492 * MiB;
constexpr size_t WS_WSH1F8 = 520 * MiB;
constexpr size_t WS_WSH2F8 = 524 * MiB;
constexpr size_t WS_ROUTE = 528 * MiB;
constexpr size_t WS_R = 534 * MiB;
constexpr size_t WS_P = WS_R, WS_Y = WS_R + 320 * MiB;
constexpr size_t WS_ACT = WS_R, WS_YBUF = WS_R + 256 * MiB;
constexpr size_t WS_XB = WS_R + 704 * MiB;
constexpr size_t WS_H8 = WS_R + 640 * MiB;
constexpr size_t WS_SHOUT = WS_R + 924 * MiB;
constexpr size_t WS_WABIN = WS_SHOUT + 128 * MiB;
constexpr size_t WS_WABOUT = WS_WABIN + 13 * MiB;
constexpr size_t WS_WCDIN = WS_WABOUT + 9 * MiB;
constexpr size_t WS_WCDOUT = WS_WCDIN + 21 * MiB;
constexpr size_t WS_LISTS = WS_WCDOUT + 9 * MiB;
constexpr size_t WS_END = WS_LISTS + 24 * MiB;
constexpr size_t RT_ROWTOK = WS_LISTS, RT_ROWDST = RT_ROWTOK + (size_t)MAXROWS * 4, RT_ROWW = RT_ROWDST + (size_t)MAXROWS * 4;
static_assert(RT_ROWW + (size_t)MAXROWS * 4 <= WS_END, "route map");
constexpr int CW_BAR = 4096;
constexpr int CW_GCNT = 16384;
constexpr int CW_NTILES = 16384 + 256;

constexpr int RING_BYTES = 131072;
constexpr int MISC_OFF = RING_BYTES;
constexpr int SIDE_TILEE = 131072 + 4096;
constexpr int SIDE_ROWS = 131072 + 8192;
constexpr int LDS_BYTES = 147456;

__device__ __forceinline__ unsigned cvt_pk_bf16(float lo, float hi) { unsigned r; asm volatile("v_cvt_pk_bf16_f32 %0, %1, %2" : "=v"(r) : "v"(lo), "v"(hi)); return r; }
__device__ __forceinline__ float bf_lo(unsigned w) { return __builtin_bit_cast(float, w << 16); }
__device__ __forceinline__ float bf_hi(unsigned w) { return __builtin_bit_cast(float, w & 0xffff0000u); }
__device__ __forceinline__ float fast_sigmoid(float x) { return __builtin_amdgcn_rcpf(1.0f + __builtin_amdgcn_exp2f(-1.44269504f * x)); }
__device__ __forceinline__ float fast_silu(float x) { return x * fast_sigmoid(x); }
__device__ __forceinline__ float shfl_xor_l(float v, int o, int lane) { return __builtin_bit_cast(float, __builtin_amdgcn_ds_bpermute((lane ^ o) << 2, __builtin_bit_cast(int, v))); }
__device__ __forceinline__ float rdlane(float v, int j) { return __builtin_bit_cast(float, __builtin_amdgcn_readlane(__builtin_bit_cast(int, v), j)); }
template <int CTRL, int ROWM = 0xf> __device__ __forceinline__ float dpp_f(float old, float src) {
    return __builtin_bit_cast(float, __builtin_amdgcn_update_dpp(__builtin_bit_cast(int, old), __builtin_bit_cast(int, src), CTRL, ROWM, 0xf, false)); }
__device__ __forceinline__ float wave_sum(float v, int) {
    v += dpp_f<0x111>(0.f, v); v += dpp_f<0x112>(0.f, v); v += dpp_f<0x114>(0.f, v); v += dpp_f<0x118>(0.f, v);
    v += dpp_f<0x142, 0xa>(0.f, v);
    v += dpp_f<0x143, 0xc>(0.f, v);
    return rdlane(v, 63);
}
__device__ __forceinline__ float wave_max(float v) {
    v = fmaxf(v, dpp_f<0x111>(v, v)); v = fmaxf(v, dpp_f<0x112>(v, v)); v = fmaxf(v, dpp_f<0x114>(v, v)); v = fmaxf(v, dpp_f<0x118>(v, v));
    v = fmaxf(v, dpp_f<0x142, 0xa>(v, v));
    v = fmaxf(v, dpp_f<0x143, 0xc>(v, v));
    return rdlane(v, 63);
}
#define LDS_WAIT() asm volatile("s_waitcnt lgkmcnt(0)" ::: "memory")
#define VM_WAIT() asm volatile("s_waitcnt vmcnt(0)" ::: "memory")

#define XB_TMO      128
#define XB_XCNT(j)  (256  + 64 * (j))
#define XB_XSUB(j)  (1280 + 64 * (j))
#define XB_XGEN(j)  (2304 + 64 * (j))
#define XB_TOP      3328
#define XB_TOPGEN   3392
#define XCD_BAR_WORDS 3456
#define XB_SPIN_CAP (1u << 20)
__device__ __forceinline__ unsigned xb_ld(unsigned* p)              { return __hip_atomic_load(p, __ATOMIC_RELAXED, __HIP_MEMORY_SCOPE_AGENT); }
__device__ __forceinline__ unsigned xb_add(unsigned* p, unsigned v) { return __hip_atomic_fetch_add(p, v, __ATOMIC_RELAXED, __HIP_MEMORY_SCOPE_AGENT); }
__device__ __forceinline__ unsigned xb_xcc_id() { return (unsigned)__builtin_amdgcn_s_getreg((3 << 11) | 20) & 0xFu; }
#define XB_SPIN(cond, bar) do { unsigned _sp = 0; while (cond) { __builtin_amdgcn_s_sleep(1); \
    if ((++_sp & 255u) == 0u) { if (xb_ld(&(bar)[XB_TMO])) break; if (_sp > XB_SPIN_CAP) { atomicAdd(&(bar)[XB_TMO], 1u); break; } } } } while (0)
struct XcdBarrier { unsigned* bar; unsigned x; volatile LAS unsigned* st; };
__device__ __forceinline__ XcdBarrier xcd_barrier_post(unsigned* bar, volatile LAS unsigned* st, int tid) {
    XcdBarrier b; b.bar = bar; b.x = xb_xcc_id(); b.st = st;
    if (tid == 0) (void)xb_add(&bar[XB_XCNT(b.x)], 1u);
    return b;
}
__device__ __forceinline__ void xcd_barrier_complete(unsigned* bar, unsigned x, unsigned& nloc, unsigned& nx) {
    const unsigned G = gridDim.x * gridDim.y * gridDim.z;
    unsigned sum, cnt, mine, sp = 0u;
    for (;;) {
        sum = 0u; cnt = 0u; mine = 0u;
#pragma unroll
        for (unsigned j = 0; j < 16; ++j) { const unsigned c = xb_ld(&bar[XB_XCNT(j)]); sum += c; cnt += (c > 0u) ? 1u : 0u; mine = (j == x) ? c : mine; }
        if (sum == G) break;
        __builtin_amdgcn_s_sleep(1);
        if ((++sp & 255u) == 0u) { if (xb_ld(&bar[XB_TMO])) break; if (sp > XB_SPIN_CAP) { atomicAdd(&bar[XB_TMO], 1u); break; } }
    }
    nloc = mine > 0u ? mine : 1u; nx = cnt > 0u ? cnt : 1u;
}
__device__ __forceinline__ void xcd_barrier(const XcdBarrier& b, int tid) {
    asm volatile("s_waitcnt vmcnt(0)" ::: "memory");
    __syncthreads();
    if (tid == 0) {
        unsigned* bar = b.bar; unsigned bx = b.x; asm volatile("" : "+s"(bar), "+s"(bx));
        __builtin_amdgcn_s_waitcnt(0);
        unsigned nloc = b.st[0], nx = b.st[1];
        if (nloc == 0u) { xcd_barrier_complete(bar, bx, nloc, nx); b.st[0] = nloc; b.st[1] = nx; }
        const unsigned old = xb_add(&bar[XB_XSUB(bx)], 1u);
        const unsigned gen = old / nloc;
        if (old + 1u == (gen + 1u) * nloc) {
            __builtin_amdgcn_fence(__ATOMIC_RELEASE, "agent");
            asm volatile("s_waitcnt vmcnt(0)" ::: "memory");
            const unsigned og = xb_add(&bar[XB_TOP], 1u);
            const unsigned tg = og / nx;
            if (og + 1u == (tg + 1u) * nx) xb_add(&bar[XB_TOPGEN], 1u);
            else XB_SPIN(xb_ld(&bar[XB_TOPGEN]) == tg, bar);
            __builtin_amdgcn_fence(__ATOMIC_ACQUIRE, "agent");
            xb_add(&bar[XB_XGEN(bx)], 1u);
            asm volatile("s_waitcnt vmcnt(0)" ::: "memory");
        } else {
            XB_SPIN(xb_ld(&bar[XB_XGEN(bx)]) == gen, bar);
            __builtin_amdgcn_fence(__ATOMIC_ACQUIRE, "agent");
            asm volatile("s_waitcnt vmcnt(0)" ::: "memory");
        }
    }
    __syncthreads();
}

namespace pg8 {
constexpr int BM = 256, BK = 64, HALF = 128, HTB = HALF * BK * 2, STAGE_BYTES = 8 * HTB, NXCD = 8, WGM = 8;
__host__ __device__ __forceinline__ int lds_byte(int r, int c) { const int st = (r >> 4) * 2 + (c >> 5), rr = r & 15, cc = c & 31, ob = rr * 64 + cc * 2; return st * 1024 + (ob ^ (((ob >> 9) & 1) << 5)); }
__host__ __device__ __forceinline__ void stage_rc(int b, int& R, int& C) { const int st = b / 1024, sb = b % 1024, swz = sb ^ (((sb >> 9) & 1) << 5); R = (st >> 1) * 16 + swz / 64; C = (st & 1) * 32 + (swz % 64) / 2; }
__host__ __device__ __forceinline__ int perm32(int rho) { const int n = rho >> 4, i = rho & 15; return 8 * (i >> 2) + 4 * n + (i & 3); }

struct Unit { int pm, pn, e, rb, nv; };

__device__ __forceinline__ int xcd_remap(int L, int nwg) { const int q = nwg / NXCD, r = nwg % NXCD, xcd = L % NXCD, off = L / NXCD; return (xcd < r ? xcd * (q + 1) : r * (q + 1) + (xcd - r) * q) + off; }

struct StaticOrder {
    static constexpr bool SIDE = false;
    const char* A; const char* Bt; size_t tstepA, tstepB; int nM, nN, nwg, G, c;
    __device__ void init(const void* A_, const void* Bt_, int K, int M, int N, int G_, int c_, int es = 2, int lda = 0, int ldb = 0) { A = (const char*)A_; Bt = (const char*)Bt_; tstepA = (size_t)BM * (lda ? lda : K * es); tstepB = (size_t)BM * (ldb ? ldb : K * es); nM = M / BM; nN = N / BM; nwg = nM * nN; G = G_; c = c_; }
    __device__ __forceinline__ bool next(int i, Unit& u) const {
        const int L = i * G + c; if (L >= nwg) return false;
        const int wgid = xcd_remap(L, nwg);
        const int nig = WGM * nN, gid = wgid / nig, fm = gid * WGM, gsz = (nM - fm) < WGM ? (nM - fm) : WGM;
        u.pm = fm + ((wgid % nig) % gsz); u.pn = (wgid % nig) / gsz; u.e = 0; u.rb = u.pm * BM; u.nv = BM; return true;
    }
    __device__ __forceinline__ const char* a_ptr(const Unit& u) const { return A + (size_t)u.pm * tstepA; }
    __device__ __forceinline__ const char* b_ptr(const Unit& u) const { return Bt + (size_t)u.pn * tstepB; }
    __device__ __forceinline__ const int* side_ptr(const Unit&, int) const { return nullptr; }
};
template <int TSTEP  , int BSTRIDE  , int NN  , bool GATHER_>
struct ExpertOrder {
    static constexpr bool SIDE = true;
    const char* A; const char* Bt; const LAS int* tile_lds; const int* side0; const int* side1; int nwg, G, c;
    __device__ __forceinline__ bool next(int i, Unit& u) const {
        const int L = i * G + c; if (L >= nwg) return false;
        const int wgid = xcd_remap(L, nwg);
        u.pm = wgid / NN; u.pn = wgid % NN;
        const int t = __builtin_amdgcn_readfirstlane(tile_lds[u.pm]);
        u.e = (int)((unsigned)t >> 26); u.rb = u.e * ECAP + ((t >> 16) & 127) * BM; u.nv = t & 0x1ff; return true;
    }
    __device__ __forceinline__ const char* a_ptr(const Unit& u) const { return GATHER_ ? A : A + (size_t)u.pm * TSTEP; }
    __device__ __forceinline__ const char* b_ptr(const Unit& u) const { return Bt + (size_t)u.e * BSTRIDE + (size_t)u.pn * TSTEP; }
    __device__ __forceinline__ const int* side_ptr(const Unit& u, int wid) const { return (wid < 4 ? side0 : side1) + (size_t)u.rb + (wid & 3) * 64; }
};
struct EpiBf16 {
    static constexpr int PERM = 1;
    bf16_t* O; int ldc; float scl;
    __device__ __forceinline__ int nst(const Unit&) const { return 16; }
    __device__ __forceinline__ void operator()(const f32x4 (&acc)[2][2][4][2], const Unit& u, int tid_in, const LAS unsigned char* side) const {
        int t_ = tid_in; asm volatile("" : "+v"(t_));
        const int wid_ = __builtin_amdgcn_readfirstlane(t_ >> 6), wr = wid_ >> 2, wc = wid_ & 3, fr = t_ & 15, fq = (t_ & 63) >> 4;
        const int row0 = u.pm * BM + wr * 64 + fr, col0 = u.pn * BM + wc * 32 + 8 * fq;
#pragma unroll
        for (int ai = 0; ai < 2; ++ai)
#pragma unroll
            for (int m = 0; m < 4; ++m) { bf16_t* rowp = O + (size_t)(row0 + ai * HALF + m * 16) * ldc + col0;
#pragma unroll
                for (int bj = 0; bj < 2; ++bj) { const f32x4 v0 = acc[ai][bj][m][0] * scl, v1 = acc[ai][bj][m][1] * scl;
                    u32x4 w; w.x = cvt_pk_bf16(v0[0], v0[1]); w.y = cvt_pk_bf16(v0[2], v0[3]); w.z = cvt_pk_bf16(v1[0], v1[1]); w.w = cvt_pk_bf16(v1[2], v1[3]);
                    *(u32x4*)(rowp + bj * HALF) = w; } }
    }
};
template <bool BASE_F32> struct EpiResGate {
    static constexpr int PERM = 1;
    const void* base; bf16_t* out; const float* gate; int mode; float scl;
    __device__ __forceinline__ int nst(const Unit&) const { return (PROBE_N > 0 && mode == 2) ? 0 : 8; }
    __device__ __forceinline__ void operator()(const f32x4 (&acc)[2][2][4][2], const Unit& u, int tid_in, const LAS unsigned char* side) const {
        if (PROBE_N > 0 && mode == 2) { if (acc[0][0][0][0][0] != 123.456f && acc[1][1][3][1][3] != 0.1234f) return; }
        int t_ = tid_in; asm volatile("" : "+v"(t_));
        const int wid_ = __builtin_amdgcn_readfirstlane(t_ >> 6), wr = wid_ >> 2, wc = wid_ & 3, fr = t_ & 15, fq = (t_ & 63) >> 4;
        const int row0 = u.pm * BM + wr * 64 + fr, col0 = u.pn * BM + wc * 32 + 8 * fq;
        const float* gp = gate + (size_t)(u.pm >> 3) * DM + col0;
        f32x4 gv[2][2];
#pragma unroll
        for (int bj = 0; bj < 2; ++bj)
#pragma unroll
            for (int n = 0; n < 2; ++n) gv[bj][n] = *(const f32x4*)(gp + bj * HALF + n * 4) * scl;
#pragma unroll
        for (int ai = 0; ai < 2; ++ai) {
            f32x4 b0[4][2], b1[4][2];
#pragma unroll
            for (int m = 0; m < 4; ++m) { const size_t off = (size_t)(row0 + ai * HALF + m * 16) * DM + col0;
#pragma unroll
                for (int bj = 0; bj < 2; ++bj) {
                    if constexpr (BASE_F32) { b0[m][bj] = *(const f32x4*)((const float*)base + off + bj * HALF); b1[m][bj] = *(const f32x4*)((const float*)base + off + bj * HALF + 4); }
                    else { const u32x4 t = *(const u32x4*)((const bf16_t*)base + off + bj * HALF); b0[m][bj] = (f32x4){bf_lo(t.x), bf_hi(t.x), bf_lo(t.y), bf_hi(t.y)}; b1[m][bj] = (f32x4){bf_lo(t.z), bf_hi(t.z), bf_lo(t.w), bf_hi(t.w)}; } } }
#pragma unroll
            for (int m = 0; m < 4; ++m) { const size_t off = (size_t)(row0 + ai * HALF + m * 16) * DM + col0;
#pragma unroll
                for (int bj = 0; bj < 2; ++bj) { const f32x4 v0 = b0[m][bj] + gv[bj][0] * acc[ai][bj][m][0], v1 = b1[m][bj] + gv[bj][1] * acc[ai][bj][m][1];
                    u32x4 w; w.x = cvt_pk_bf16(v0[0], v0[1]); w.y = cvt_pk_bf16(v0[2], v0[3]); w.z = cvt_pk_bf16(v1[0], v1[1]); w.w = cvt_pk_bf16(v1[2], v1[3]);
                    *(u32x4*)(out + off + bj * HALF) = w; } }
        }
    }
};
struct EpiCdIn {
    static constexpr int PERM = 1;
    bf16_t* O; float scl;
    __device__ __forceinline__ int nst(const Unit& u) const { return u.pn < 4 ? 16 : 8; }
    __device__ __forceinline__ void operator()(const f32x4 (&acc)[2][2][4][2], const Unit& u, int tid_in, const LAS unsigned char* side) const {
        int t_ = tid_in; asm volatile("" : "+v"(t_));
        const int wid_ = __builtin_amdgcn_readfirstlane(t_ >> 6), wr = wid_ >> 2, wc = wid_ & 3, fr = t_ & 15, fq = (t_ & 63) >> 4;
        const int row0 = u.pm * BM + wr * 64 + fr, oc = wc * 32 + 8 * fq;
        if (u.pn < 4) {
#pragma unroll
            for (int ai = 0; ai < 2; ++ai)
#pragma unroll
                for (int m = 0; m < 4; ++m) { bf16_t* rowp = O + (size_t)(row0 + ai * HALF + m * 16) * 3072 + u.pn * BM + oc;
#pragma unroll
                    for (int bj = 0; bj < 2; ++bj) { const f32x4 v0 = acc[ai][bj][m][0] * scl, v1 = acc[ai][bj][m][1] * scl;
                        u32x4 w; w.x = cvt_pk_bf16(v0[0], v0[1]); w.y = cvt_pk_bf16(v0[2], v0[3]); w.z = cvt_pk_bf16(v1[0], v1[1]); w.w = cvt_pk_bf16(v1[2], v1[3]);
                        *(u32x4*)(rowp + bj * HALF) = w; } }
            return;
        }
        const bool gate = u.pn >= 12; const int ocol = (gate ? 2048 + (u.pn - 12) * HALF : 1024 + (u.pn - 4) * HALF) + oc;
#pragma unroll
        for (int ai = 0; ai < 2; ++ai)
#pragma unroll
            for (int m = 0; m < 4; ++m) { float r[8];
#pragma unroll
                for (int n = 0; n < 2; ++n)
#pragma unroll
                    for (int j = 0; j < 4; ++j) { const float a = acc[ai][0][m][n][j] * scl, b = acc[ai][1][m][n][j] * scl; r[n * 4 + j] = a * (gate ? fast_sigmoid(b) : b); }
                u32x4 w; w.x = cvt_pk_bf16(r[0], r[1]); w.y = cvt_pk_bf16(r[2], r[3]); w.z = cvt_pk_bf16(r[4], r[5]); w.w = cvt_pk_bf16(r[6], r[7]);
                *(u32x4*)(O + (size_t)(row0 + ai * HALF + m * 16) * 3072 + ocol) = w; }
    }
};
struct EpiSiluMul {
    static constexpr int PERM = 1;
    bf16_t* O; int ldc; float* logits; int router_pn; float scl;
    __device__ __forceinline__ void operator()(const f32x4 (&acc)[2][2][4][2], const Unit& u, int tid_in, const LAS unsigned char* side) const {
        int t_ = tid_in; asm volatile("" : "+v"(t_));
        const int wid_ = __builtin_amdgcn_readfirstlane(t_ >> 6), wr = wid_ >> 2, wc = wid_ & 3, fr = t_ & 15, fq = (t_ & 63) >> 4;
        const int row0 = u.pm * BM + wr * 64 + fr, oc = wc * 32 + 8 * fq;
        if (u.pn == router_pn) {
            if (wc < 2) {
#pragma unroll
                for (int ai = 0; ai < 2; ++ai)
#pragma unroll
                    for (int m = 0; m < 4; ++m) { float* rp = logits + (size_t)(row0 + ai * HALF + m * 16) * NE + oc;
                        *(f32x4*)rp = acc[ai][0][m][0]; *(f32x4*)(rp + 4) = acc[ai][0][m][1]; }
            }
            return;
        }
#pragma unroll
        for (int ai = 0; ai < 2; ++ai)
#pragma unroll
            for (int m = 0; m < 4; ++m) { bf16_t* rowp = O + (size_t)(row0 + ai * HALF + m * 16) * ldc + u.pn * HALF + oc;
                float r[8];
#pragma unroll
                for (int n = 0; n < 2; ++n)
#pragma unroll
                    for (int j = 0; j < 4; ++j) r[n * 4 + j] = fast_silu(acc[ai][0][m][n][j] * scl) * (acc[ai][1][m][n][j] * scl);
                u32x4 w; w.x = cvt_pk_bf16(r[0], r[1]); w.y = cvt_pk_bf16(r[2], r[3]); w.z = cvt_pk_bf16(r[4], r[5]); w.w = cvt_pk_bf16(r[6], r[7]);
                *(u32x4*)rowp = w; }
    }
};
constexpr float A8_SCALE = 8.0f;
constexpr float Y8_SCALE = 16.0f;
__device__ __forceinline__ float clamp8(float v) { return __builtin_amdgcn_fmed3f(v, -448.0f, 448.0f); }
__device__ __forceinline__ unsigned pk4_fp8(float a, float b, float c, float d) { int w = __builtin_amdgcn_cvt_pk_fp8_f32(a, b, 0, false); w = __builtin_amdgcn_cvt_pk_fp8_f32(c, d, w, true); return (unsigned)w; }
constexpr float Y8M_SCALE = 2.0f;
__device__ __forceinline__ unsigned pk4_fp8c(float a, float b, float c, float d) { return pk4_fp8(clamp8(a * Y8M_SCALE), clamp8(b * Y8M_SCALE), clamp8(c * Y8M_SCALE), clamp8(d * Y8M_SCALE)); }
struct EpiSiluMul8 {
    static constexpr int PERM = 1;
    unsigned char* O; int ldc; float scl; int last_pn; int padc;
    __device__ __forceinline__ int nst(const Unit&) const { return 8; }
    __device__ __forceinline__ void operator()(const f32x4 (&acc)[2][2][4][2], const Unit& u, int tid_in, const LAS unsigned char* side) const {
        int t_ = tid_in; asm volatile("" : "+v"(t_));
        const int wid_ = __builtin_amdgcn_readfirstlane(t_ >> 6), wr = wid_ >> 2, wc = wid_ & 3, fr = t_ & 15, fq = (t_ & 63) >> 4;
        const int row0 = u.pm * BM + wr * 64 + fr, oc = wc * 32 + 8 * fq;
        const bool pad = (padc > 0) && (u.pn == last_pn);
#pragma unroll
        for (int ai = 0; ai < 2; ++ai)
#pragma unroll
            for (int m = 0; m < 4; ++m) { unsigned char* rowp = O + (size_t)(row0 + ai * HALF + m * 16) * ldc + u.pn * HALF + oc;
                float r[8];
#pragma unroll
                for (int n = 0; n < 2; ++n)
#pragma unroll
                    for (int j = 0; j < 4; ++j) r[n * 4 + j] = fast_silu(acc[ai][0][m][n][j] * scl) * (acc[ai][1][m][n][j] * (scl * A8_SCALE));
                u32x2 w; w.x = pk4_fp8(r[0], r[1], r[2], r[3]); w.y = pk4_fp8(r[4], r[5], r[6], r[7]);
                *(u32x2*)rowp = w;
                if (pad) *(u32x2*)(rowp + HALF) = (u32x2){0u, 0u}; }
    }
};
struct EpiScatterY {
    static constexpr int PERM = 2;
    unsigned char* Y; float wscl; int mode;
    __device__ __forceinline__ int nst(const Unit& u) const { return (u.nv == BM && !(PROBE_N > 0 && mode == 2)) ? 8 : 0; }
    __device__ __forceinline__ void operator()(const f32x4 (&acc)[2][2][4][2], const Unit& u, int tid_in, const LAS unsigned char* side) const {
        int t_ = tid_in; asm volatile("" : "+v"(t_));
        const int wid_ = __builtin_amdgcn_readfirstlane(t_ >> 6), wr = wid_ >> 2, wc = wid_ & 3, fr = t_ & 15, fq = (t_ & 63) >> 4;
        const int col0 = u.pn * BM + wc * 64 + 16 * fq;
#pragma unroll
        for (int ai = 0; ai < 2; ++ai)
#pragma unroll
            for (int m = 0; m < 4; ++m) { const int rl = wr * 64 + fr + ai * HALF + m * 16; int dst = rl < u.nv ? *(const LAS int*)(side + rl * 4) : -1; const float w = *(const LAS float*)(side + 1024 + rl * 4) * wscl;
                if (dst >= 0 && !(PROBE_N > 0 && mode == 2)) {
                    const f32x4 v0 = acc[ai][0][m][0] * w, v1 = acc[ai][0][m][1] * w, v2 = acc[ai][1][m][0] * w, v3 = acc[ai][1][m][1] * w;
                    u32x4 o; o.x = pk4_fp8(v0[0], v0[1], v0[2], v0[3]); o.y = pk4_fp8(v1[0], v1[1], v1[2], v1[3]); o.z = pk4_fp8(v2[0], v2[1], v2[2], v2[3]); o.w = pk4_fp8(v3[0], v3[1], v3[2], v3[3]);
                    *(u32x4*)(Y + (size_t)dst * DM + col0) = o; } }
    }
};
struct EpiFp8 {
    static constexpr bool PREFETCH = false;
    static constexpr int PERM = 2;
    unsigned char* O; int ldc; float scl;
    __device__ __forceinline__ int nst(const Unit&) const { return 8; }
    __device__ __forceinline__ void operator()(const f32x4 (&acc)[2][2][4][2], const Unit& u, int tid_in, const LAS unsigned char* side) const {
        int t_ = tid_in; asm volatile("" : "+v"(t_));
        const int wid_ = __builtin_amdgcn_readfirstlane(t_ >> 6), wr = wid_ >> 2, wc = wid_ & 3, fr = t_ & 15, fq = (t_ & 63) >> 4;
        const int row0 = u.pm * BM + wr * 64 + fr, col0 = u.pn * BM + wc * 64 + 16 * fq;
#pragma unroll
        for (int ai = 0; ai < 2; ++ai)
#pragma unroll
            for (int m = 0; m < 4; ++m) {
                const f32x4 v0 = acc[ai][0][m][0] * scl, v1 = acc[ai][0][m][1] * scl, v2 = acc[ai][1][m][0] * scl, v3 = acc[ai][1][m][1] * scl;
                u32x4 o; o.x = pk4_fp8(v0[0], v0[1], v0[2], v0[3]); o.y = pk4_fp8(v1[0], v1[1], v1[2], v1[3]); o.z = pk4_fp8(v2[0], v2[1], v2[2], v2[3]); o.w = pk4_fp8(v3[0], v3[1], v3[2], v3[3]);
                *(u32x4*)(O + (size_t)(row0 + ai * HALF + m * 16) * ldc + col0) = o; }
    }
};
struct EpiCombine {
    static constexpr int PERM = 0;
    const float* base; float* out; const float* gate; const bf16_t* Y;
    __device__ __forceinline__ void operator()(const f32x4 (&acc)[2][2][4][2], const Unit& u, int tid_in, const LAS unsigned char* side) const {
        int t_ = tid_in; asm volatile("" : "+v"(t_));
        const int wid_ = __builtin_amdgcn_readfirstlane(t_ >> 6), wr = wid_ >> 2, wc = wid_ & 3, fr = t_ & 15, fq = (t_ & 63) >> 4;
        const int row0 = u.pm * BM + wr * 64 + fr, col0 = u.pn * BM + wc * 32 + 4 * fq;
        const float* gp = gate + (size_t)(u.pm >> 3) * DM + col0;
        f32x4 gv[2][2];
#pragma unroll
        for (int bj = 0; bj < 2; ++bj)
#pragma unroll
            for (int n = 0; n < 2; ++n) gv[bj][n] = *(const f32x4*)(gp + bj * HALF + n * 16);
#pragma unroll
        for (int ai = 0; ai < 2; ++ai)
#pragma unroll
            for (int m = 0; m < 4; ++m) { const int r = row0 + ai * HALF + m * 16; const size_t off = (size_t)r * DM + col0; const bf16_t* yp = Y + (size_t)r * (TOPK * DM) + col0;
#pragma unroll
                for (int bj = 0; bj < 2; ++bj)
#pragma unroll
                    for (int n = 0; n < 2; ++n) { const int co = bj * HALF + n * 16;
                        f32x4 s = acc[ai][bj][m][n];
#pragma unroll
                        for (int k = 0; k < TOPK; ++k) { const u32x2 y = *(const u32x2*)(yp + (size_t)k * DM + co); s[0] += bf_lo(y.x); s[1] += bf_hi(y.x); s[2] += bf_lo(y.y); s[3] += bf_hi(y.y); }
                        const f32x4 bs = *(const f32x4*)(base + off + co);
                        *(f32x4*)(out + off + co) = bs + gv[bj][n] * s; }
                asm volatile("" ::: "memory"); }
    }
};

template <class Epi, class Sched, int K, bool GATHER, int ES = 2, bool ALIGN_EPI = true, int LDA = 0, int LDB = 0, bool ZLAST = false>
__device__ __forceinline__ void gemm_phase(LAS unsigned char* lds, const Sched& S, const Epi& E, const int tid) {
    const int wid = __builtin_amdgcn_readfirstlane(tid >> 6), lane = tid & 63, wr = wid >> 2, wc = wid & 3, fr = lane & 15, fq = lane >> 4;
    constexpr int PA = LDA ? LDA : K * ES, PB = LDB ? LDB : K * ES;
    constexpr int BKE = BK * 2 / ES;
    constexpr int nt = K / BKE;
    static_assert(K % (2 * BKE) == 0 && K >= 4 * BKE, "K");
    unsigned voffA[2], voffB[2][2]; int RA[2]; unsigned CA2[2];
#pragma unroll
    for (int i = 0; i < 2; ++i) { int R, C; stage_rc(tid * 16 + i * 8192, R, C);
        voffA[i] = (unsigned)(R * PA + C * 2); RA[i] = R; CA2[i] = (unsigned)C * 2u;
#pragma unroll
        for (int h = 0; h < 2; ++h) { const int Rb = Epi::PERM == 2 ? (64 * (R >> 5) + 16 * ((R & 15) >> 2) + 8 * h + 4 * ((R >> 4) & 1) + (R & 3)) : (h * HALF + (Epi::PERM == 1 ? ((R & ~31) + perm32(R & 31)) : R));
            voffB[h][i] = (unsigned)(Rb * PB + C * 2); } }
    constexpr size_t kstep = (size_t)(BK * 2);
    constexpr size_t hstep = (size_t)HALF * PA;
    const unsigned ldsw = (unsigned)wid * 1024u;
    const int aoff = lds_byte(wr * 64 + fr, fq * 8), boff = lds_byte(wc * 32 + fr, fq * 8);
    constexpr int KST = 1024;
#define PG8_SA(b, h) (((b) * 2 + (h)) * HTB)
#define PG8_SB(b, h) ((4 + (b) * 2 + (h)) * HTB)
#define PG8_STAGE(bufoff, gbase, voff) do { const char* _gb = (const char*)(gbase); asm volatile("" : "+s"(_gb)); _Pragma("unroll") for (int _i = 0; _i < 2; ++_i) { \
        unsigned _vo = (voff)[_i]; asm volatile("" : "+v"(_vo)); __builtin_amdgcn_global_load_lds((const unsigned*)(_gb + _vo), (LAS unsigned*)(lds + (bufoff) + ldsw + _i * 8192), 16, 0, 0); } } while (0)
#define PG8_STAGE_A(bufoff, h, p, go) do { if constexpr (GATHER) { PG8_STAGE(bufoff, p, (go)[h]); } else { PG8_STAGE(bufoff, (p) + (h) * hstep, voffA); } } while (0)
#define PG8_STAGE_B(bufoff, h, p) PG8_STAGE(bufoff, p, voffB[h])
#define PG8_LDA(dst, b, h) do { _Pragma("unroll") for (int m = 0; m < 4; ++m) _Pragma("unroll") for (int k = 0; k < 2; ++k) dst[m][k] = *(const LAS bf16x8*)(lds + PG8_SA(b, h) + aoff + m * 2048 + k * KST); } while (0)
#define PG8_LDB(dst, b, h) do { _Pragma("unroll") for (int n = 0; n < 2; ++n) _Pragma("unroll") for (int k = 0; k < 2; ++k) dst[n][k] = *(const LAS bf16x8*)(lds + PG8_SB(b, h) + boff + n * 2048 + k * KST); } while (0)
#define PG8_MMA(ai, bj, At, Bt) do { __builtin_amdgcn_s_setprio(1); _Pragma("unroll") for (int m = 0; m < 4; ++m) _Pragma("unroll") for (int n = 0; n < 2; ++n) { \
        if constexpr (ES == 2) { _Pragma("unroll") for (int k = 0; k < 2; ++k) acc[ai][bj][m][n] = __builtin_amdgcn_mfma_f32_16x16x32_bf16(Bt[n][k], At[m][k], acc[ai][bj][m][n], 0, 0, 0); } \
        else { acc[ai][bj][m][n] = __builtin_amdgcn_mfma_scale_f32_16x16x128_f8f6f4(__builtin_shufflevector((i32x4)Bt[n][0], (i32x4)Bt[n][1], 0, 1, 2, 3, 4, 5, 6, 7), \
                                                                                     __builtin_shufflevector((i32x4)At[m][0], (i32x4)At[m][1], 0, 1, 2, 3, 4, 5, 6, 7), acc[ai][bj][m][n], 0, 0, 0, 0, 0, 0); } } \
        __builtin_amdgcn_s_setprio(0); } while (0)
#define PG8_SIDE(u, idx) do { if constexpr (Sched::SIDE) { const int* _sp = S.side_ptr(u, wid); int _t = tid; asm volatile("" : "+v"(_t)); const unsigned _l4 = (unsigned)(_t & 63) * 4u;     \
        __builtin_amdgcn_global_load_lds((const unsigned*)((const char*)_sp + _l4), (LAS unsigned*)(lds + SIDE_ROWS + ((idx) % 3) * 2048 + wid * 256), 4, 0, 0); } } while (0)
#define PG8_WAIT_V(n) asm volatile("s_waitcnt vmcnt(" #n ")" ::: "memory")
#define PG8_WAIT_L(n) asm volatile("s_waitcnt lgkmcnt(" #n ")" ::: "memory")
#define PG8_BAR __builtin_amdgcn_s_barrier()
#define PG8_SCHED __builtin_amdgcn_sched_barrier(0)
#define PG8_WAIT_VS(n0, n8, n16) do { if (lzt == 0) PG8_WAIT_V(n0); else if (lzt == 8) PG8_WAIT_V(n8); else PG8_WAIT_V(n16); } while (0)
    Unit cur, nxt; int ui = 0; int lz = 0;
    if (!S.next(0, cur)) return;
    f32x4 acc[2][2][4][2];
#pragma unroll
    for (int a = 0; a < 2; ++a)
#pragma unroll
        for (int b = 0; b < 2; ++b)
#pragma unroll
            for (int m = 0; m < 4; ++m)
#pragma unroll
                for (int n = 0; n < 2; ++n) acc[a][b][m][n] = (f32x4){0.f, 0.f, 0.f, 0.f};
    bf16x8 At[4][2], B0[2][2], B1[2][2];
    unsigned gcur[2][2] = {{0u, 0u}, {0u, 0u}};
    const char* cA = S.a_ptr(cur); const char* cB = S.b_ptr(cur);
    if constexpr (GATHER) { const int* rl = S.side0 + (size_t)cur.rb;
#pragma unroll
        for (int h = 0; h < 2; ++h)
#pragma unroll
            for (int i = 0; i < 2; ++i) { const int ri = h * HALF + RA[i]; const int tk = ri < cur.nv ? rl[ri] : 0;
                gcur[h][i] = (unsigned)tk * (unsigned)PA + CA2[i]; asm volatile("" : "+v"(gcur[h][i])); } }
    PG8_SIDE(cur, 0);
    PG8_STAGE_B(PG8_SB(0, 0), 0, cB); PG8_STAGE_B(PG8_SB(0, 1), 1, cB); PG8_STAGE_A(PG8_SA(0, 0), 0, cA, gcur); PG8_STAGE_A(PG8_SA(0, 1), 1, cA, gcur);
    if (wr == 1) PG8_BAR;
    PG8_WAIT_V(2); PG8_BAR;
    PG8_STAGE_B(PG8_SB(1, 0), 0, cB + kstep); PG8_STAGE_A(PG8_SA(1, 0), 0, cA + kstep, gcur); PG8_STAGE_B(PG8_SB(1, 1), 1, cB + kstep);
    PG8_WAIT_V(6); PG8_BAR;
    for (;;) {
        const bool has_next = S.next(ui + 1, nxt);
        const char* nA = has_next ? S.a_ptr(nxt) : cA; const char* nB = has_next ? S.b_ptr(nxt) : cB;
        if (has_next) PG8_SIDE(nxt, ui + 1);
#pragma nounroll
        for (int t = 0; t < nt; t += 2) {
            const bool last = (t == nt - 2);
            const int lzt = (t == 0) ? lz : 0;
            const char* a1 = cA + (size_t)(t + 1) * kstep;
            const char* a2 = last ? nA : cA + (size_t)(t + 2) * kstep; const char* b2 = last ? nB : cB + (size_t)(t + 2) * kstep;
            const char* a3 = a2 + kstep; const char* b3 = b2 + kstep;
            static_assert(!GATHER || nt >= 4, "gather needs a few K-tiles of lead for the side list");
            PG8_LDB(B0, 0, 0); PG8_LDB(B1, 0, 1); PG8_SCHED; PG8_LDA(At, 0, 0); if (!(t == 0 && ui > 0) && !(ZLAST && last)) PG8_STAGE_A(PG8_SA(1, 1), 1, a1, gcur);
            if constexpr (GATHER) { if (last && has_next) {
                int t2_ = tid; asm volatile("" : "+v"(t2_));
#pragma unroll
                for (int i = 0; i < 2; ++i) { int R, C; stage_rc(t2_ * 16 + i * 8192, R, C);
#pragma unroll
                    for (int h = 0; h < 2; ++h) { const int ri = h * HALF + R; const int tk = ri < nxt.nv ? *(const LAS int*)(lds + SIDE_ROWS + ((ui + 1) % 3) * 2048 + ri * 4) : 0;
                        gcur[h][i] = (unsigned)tk * (unsigned)PA + (unsigned)C * 2u; } } } }
            if (ZLAST && last) PG8_WAIT_V(0); else PG8_WAIT_VS(8, 16, 24);
            PG8_WAIT_L(0); PG8_BAR; PG8_MMA(0, 0, At, B0); PG8_MMA(0, 1, At, B1); PG8_BAR; PG8_SCHED;
            PG8_LDA(At, 0, 1); PG8_STAGE_B(PG8_SB(0, 0), 0, b2); PG8_STAGE_B(PG8_SB(0, 1), 1, b2); PG8_STAGE_A(PG8_SA(0, 0), 0, a2, gcur);
            PG8_WAIT_VS(8, 16, 24);
            PG8_WAIT_L(0); PG8_BAR; PG8_MMA(1, 0, At, B0); PG8_MMA(1, 1, At, B1); PG8_BAR; PG8_SCHED;
            const bool zskip = ZLAST && last;
            if (!zskip) { PG8_LDB(B0, 1, 0); PG8_LDB(B1, 1, 1); PG8_SCHED; PG8_LDA(At, 1, 0); } PG8_STAGE_A(PG8_SA(0, 1), 1, a2, gcur);
            PG8_WAIT_VS(8, 16, 24); PG8_WAIT_L(0); PG8_BAR; if (!zskip) { PG8_MMA(0, 0, At, B0); PG8_MMA(0, 1, At, B1); } PG8_BAR; PG8_SCHED;
            if (!zskip) { PG8_LDA(At, 1, 1); } if (!(ZLAST && !last)) { PG8_STAGE_B(PG8_SB(1, 0), 0, b3); PG8_STAGE_B(PG8_SB(1, 1), 1, b3); PG8_STAGE_A(PG8_SA(1, 0), 0, a3, gcur); }
            if constexpr (ZLAST) { static_assert(!ZLAST || nt == 4, "ZLAST: hand-counted for four K-tiles"); if (last) PG8_WAIT_V(8); else PG8_WAIT_V(2); }
            else PG8_WAIT_V(8);
            PG8_WAIT_L(0); PG8_BAR; if (!zskip) { PG8_MMA(1, 0, At, B0); PG8_MMA(1, 1, At, B1); } PG8_BAR; PG8_SCHED;
            if (last && has_next) PG8_STAGE_A(PG8_SA(1, 1), 1, a3, gcur);
        }
        if constexpr (ALIGN_EPI) { if (wr == 0) PG8_BAR; }
        E(acc, cur, tid, lds + SIDE_ROWS + (ui % 3) * 2048);
        if (!has_next) break;
        lz = E.nst(cur);
#pragma unroll
        for (int a = 0; a < 2; ++a)
#pragma unroll
            for (int b = 0; b < 2; ++b)
#pragma unroll
                for (int m = 0; m < 4; ++m)
#pragma unroll
                    for (int n = 0; n < 2; ++n) acc[a][b][m][n] = (f32x4){0.f, 0.f, 0.f, 0.f};
        cur = nxt; cA = nA; cB = nB; ++ui;
        if constexpr (ALIGN_EPI) { if (wr == 1) PG8_BAR; }
    }
    PG8_WAIT_V(0);
    if constexpr (!ALIGN_EPI) { if (wr == 0) PG8_BAR; }
    PG8_BAR;
#undef PG8_SA
#undef PG8_SB
#undef PG8_STAGE
#undef PG8_STAGE_A
#undef PG8_STAGE_B
#undef PG8_SIDE
#undef PG8_LDA
#undef PG8_LDB
#undef PG8_MMA
#undef PG8_WAIT_V
#undef PG8_WAIT_VS
#undef PG8_WAIT_L
#undef PG8_BAR
#undef PG8_SCHED
}
}

struct Args { const float* in[31]; float* out; unsigned char* ws; int ph_lo, ph_hi; int probe, pad; };
enum { I_X = 0, I_C, I_ADAW, I_ADAB, I_NMIXG, I_NFFNG, I_ABWIN, I_SGULNG, I_SGULNB, I_SGUW, I_SGUB, I_POOLW, I_POOLSC, I_ABWOUT, I_CDWIN, I_C3W, I_C3B, I_C31W, I_C31B, I_CDLNG, I_CDLNB, I_CDWOUT,
       I_RW, I_RB, I_EW1, I_EW3, I_EW2, I_SW1, I_SW3, I_SW2, I_FG };

__device__ __forceinline__ void ph_mod_partial(const float* c, const float* ada_w, float* modp, LAS unsigned char* lds, int blk, int nblk, const int tid) {
    const int wave = __builtin_amdgcn_readfirstlane(tid >> 6), lane = tid & 63;
    LAS float* red = (LAS float*)lds;
    for (int task = blk; task < 384; task += nblk) {
        const int l = task / 192, rem = task % 192, nb = rem >> 2, kq = rem & 3;
        const int k0 = kq * 512 + wave * 64;
        int cv[16];
#pragma unroll
        for (int b = 0; b < 16; ++b) { const float x = c[b * DM + k0 + lane]; cv[b] = __builtin_bit_cast(int, x / (1.0f + __expf(-x))); }
        f32x4 acc[16];
#pragma unroll
        for (int b = 0; b < 16; ++b) acc[b] = (f32x4){0.f, 0.f, 0.f, 0.f};
        const float* wp = ada_w + ((size_t)l * DM + k0) * (6 * DM) + nb * 256 + lane * 4;
#pragma unroll 8
        for (int kk = 0; kk < 64; ++kk) {
            const f32x4 w = *(const f32x4*)(wp + (size_t)kk * (6 * DM));
#pragma unroll
            for (int b = 0; b < 16; ++b) { const float s = __builtin_bit_cast(float, __builtin_amdgcn_readlane(cv[b], kk)); acc[b] += w * s; }
        }
#pragma unroll
        for (int b = 0; b < 16; ++b) *(LAS f32x4*)(red + (wave * 16 + b) * 256 + lane * 4) = acc[b];
        __syncthreads();
#pragma unroll
        for (int j = 0; j < 2; ++j) { const int b = (tid >> 6) + 8 * j, c4 = tid & 63;
            f32x4 s = (f32x4){0.f, 0.f, 0.f, 0.f};
#pragma unroll
            for (int w = 0; w < 8; ++w) s += *(const LAS f32x4*)(red + (w * 16 + b) * 256 + c4 * 4);
            *(f32x4*)(modp + ((size_t)((kq * 2 + l) * 16 + b)) * (6 * DM) + nb * 256 + c4 * 4) = s; }
        __syncthreads();
    }
}
__device__ __forceinline__ void ph_mod_final(const float* modp, const float* ada_b, float* modf, int gtid, int ngt) {
    for (int i = gtid; i < 2 * 6 * 16 * DM; i += ngt) {
        const int d = i & (DM - 1), b = (i >> 11) & 15, j = (i >> 15) % 6, l = i / (6 * 16 * DM);
        const size_t src = ((size_t)(l * 16 + b)) * (6 * DM) + j * DM + d;
        float s = ada_b[l * 6 * DM + j * DM + d];
#pragma unroll
        for (int kq = 0; kq < 4; ++kq) s += modp[(size_t)kq * (2 * 16 * 6 * DM) + src];
        if (j == 1 || j == 4) s += 1.0f;
        modf[i] = s;
    }
}
__device__ __forceinline__ void conv_item(const float* W, int N, int k0, int n0, bf16_t* dst, int ldd, LAS float* scr, int lane) {
    float wv[32];
#pragma unroll
    for (int i = 0; i < 32; ++i) { const int kk = 2 * i + (lane >> 5); wv[i] = W[(size_t)(k0 + kk) * N + n0 + (lane & 31)]; }
#pragma unroll
    for (int i = 0; i < 32; ++i) { const int kk = 2 * i + (lane >> 5); scr[kk * 33 + (lane & 31)] = wv[i]; }
    LDS_WAIT(); asm volatile("" ::: "memory");
    const int c = lane & 7;
#pragma unroll
    for (int j = 0; j < 4; ++j) { const int n = (lane >> 3) + 8 * j; const LAS float* s = scr + (8 * c) * 33 + n;
        u32x4 o; o.x = cvt_pk_bf16(s[0 * 33], s[1 * 33]); o.y = cvt_pk_bf16(s[2 * 33], s[3 * 33]); o.z = cvt_pk_bf16(s[4 * 33], s[5 * 33]); o.w = cvt_pk_bf16(s[6 * 33], s[7 * 33]);
        *(u32x4*)(dst + (size_t)n * ldd + k0 + 8 * c) = o; }
    LDS_WAIT(); asm volatile("" ::: "memory");
}
constexpr float W8_SCALE = 64.0f;
__device__ __forceinline__ void conv_item8(const float* W, int N, int k0, int n0, unsigned char* dst, int ldd, LAS float* scr, int lane) {
    float wv[32];
#pragma unroll
    for (int i = 0; i < 32; ++i) { const int kk = 2 * i + (lane >> 5); wv[i] = W[(size_t)(k0 + kk) * N + n0 + (lane & 31)]; }
#pragma unroll
    for (int i = 0; i < 32; ++i) { const int kk = 2 * i + (lane >> 5); scr[kk * 33 + (lane & 31)] = wv[i]; }
    LDS_WAIT(); asm volatile("" ::: "memory");
    const int c = lane & 7;
#pragma unroll
    for (int j = 0; j < 4; ++j) { const int n = (lane >> 3) + 8 * j; const LAS float* sp = scr + (8 * c) * 33 + n;
        u32x2 o; o.x = pg8::pk4_fp8(sp[0 * 33] * W8_SCALE, sp[1 * 33] * W8_SCALE, sp[2 * 33] * W8_SCALE, sp[3 * 33] * W8_SCALE); o.y = pg8::pk4_fp8(sp[4 * 33] * W8_SCALE, sp[5 * 33] * W8_SCALE, sp[6 * 33] * W8_SCALE, sp[7 * 33] * W8_SCALE);
        *(u32x2*)(dst + (size_t)n * ldd + k0 + 8 * c) = o; }
    LDS_WAIT(); asm volatile("" ::: "memory");
}
__device__ __forceinline__ void conv_gated8(const float* W, int K, int N, unsigned char* WT, int half, int item, LAS float* scr, int lane) {
    const int nblk = N / 32, kb = item / nblk, nb = item % nblk, n0 = 32 * nb;
    conv_item8(W, N, 64 * kb, n0, WT + (size_t)((n0 >> 7) * 256 + half * 128 + (n0 & 127)) * K, K, scr, lane);
}
__device__ __forceinline__ void conv_plain(const float* W, int K, int N, bf16_t* WT, int item, LAS float* scr, int lane) {
    const int nblk = N / 32, kb = item / nblk, nb = item % nblk;
    conv_item(W, N, 64 * kb, 32 * nb, WT + (size_t)(32 * nb) * K, K, scr, lane);
}
__device__ __forceinline__ void conv_gated(const float* W, int K, int N, bf16_t* WT, int half, int item, LAS float* scr, int lane) {
    const int nblk = N / 32, kb = item / nblk, nb = item % nblk, n0 = 32 * nb;
    conv_item(W, N, 64 * kb, n0, WT + (size_t)((n0 >> 7) * 256 + half * 128 + (n0 & 127)) * K, K, scr, lane);
}
constexpr int CV_N13 = NE * 2 * (DM / 64) * (EFF / 32), CV_N2 = NE * (EFF / 64) * (DM / 32), CV_TOT = CV_N13 + CV_N2;
#ifndef NCV_IN
#define NCV_IN 36
#define NCV_OUT 48
#define NCV_E1 24
#define NCV_IN1 40
#define CVQ_P0 25728
#define CVQ_A1 44928
#define CVQ_C 12600
#endif
struct CJob { const float* src; unsigned char* dst; int N, ldd; };
__device__ __forceinline__ CJob conv_job(const float* w1, const float* w3, const float* w2, int l, unsigned char* WE13, unsigned char* WE2, int it) {
    constexpr int I13 = (DM / 64) * (EFF / 32), I2 = (EFF / 64) * (DM / 32);
    CJob j;
    if (it < CV_N13) { const int e = it / (2 * I13); int r = it % (2 * I13); const int half = r >= I13 ? 1 : 0; r -= half * I13; const int nblk = EFF / 32, kb = r / nblk, n0 = 32 * (r % nblk);
        const size_t eo = (size_t)(l * NE + e) * DM * EFF;
        j.src = (half ? w3 : w1) + eo + (size_t)(64 * kb) * EFF + n0; j.N = EFF; j.ldd = DM;
        j.dst = WE13 + (size_t)e * 768 * DM + (size_t)((n0 >> 7) * 256 + half * 128 + (n0 & 127)) * DM + 64 * kb; }
    else { const int q = it - CV_N13, e = q / I2, r = q % I2; const int nblk = DM / 32, kb = r / nblk, n0 = 32 * (r % nblk);
        const size_t eo = (size_t)(l * NE + e) * DM * EFF;
        j.src = w2 + eo + (size_t)(64 * kb) * DM + n0; j.N = DM; j.ldd = 512;
        j.dst = WE2 + (size_t)e * DM * 512 + (size_t)n0 * 512 + 64 * kb; }
    return j;
}
__device__ __forceinline__ void conv_load(const CJob& j, float (&wv)[32], int lane) {
    const float* p = j.src + (size_t)((lane >> 5) * 32) * j.N + (lane & 31);
#pragma unroll
    for (int i = 0; i < 32; ++i) wv[i] = p[(size_t)i * j.N];
}
constexpr int CVP = 20;
__device__ __forceinline__ void conv_finish8(const CJob& j, const float (&wv)[32], LAS float* scr_, int lane) {
    LAS unsigned* scr = (LAS unsigned*)scr_;
    const int n = lane & 31, kh = lane >> 5;
#pragma unroll
    for (int i = 0; i < 8; ++i) scr[n * CVP + kh * 8 + i] = pg8::pk4_fp8(wv[4 * i] * W8_SCALE, wv[4 * i + 1] * W8_SCALE, wv[4 * i + 2] * W8_SCALE, wv[4 * i + 3] * W8_SCALE);
    LDS_WAIT(); asm volatile("" ::: "memory");
#pragma unroll
    for (int q = 0; q < 2; ++q) { const int r = (lane >> 2) + 16 * q, c = lane & 3;
        const u32x4 o = *(const LAS u32x4*)(scr + r * CVP + 4 * c);
        *(u32x4*)(j.dst + (size_t)r * j.ldd + 16 * c) = o; }
    LDS_WAIT(); asm volatile("" ::: "memory");
}
__device__ __forceinline__ void conv_range(const float* w1, const float* w3, const float* w2, int l, unsigned char* WE13, unsigned char* WE2, LAS float* scr, int first, int stride, int lo, int hi, int lane) {
    int it = lo + first;
    if (it < hi) {
        CJob a = conv_job(w1, w3, w2, l, WE13, WE2, it); float wa[32]; conv_load(a, wa, lane);
        for (;;) { const int nx = it + stride; const bool more = nx < hi;
            const CJob b = conv_job(w1, w3, w2, l, WE13, WE2, more ? nx : it); float wb[32]; conv_load(b, wb, lane);
            conv_finish8(a, wa, scr, lane);
            if (!more) break;
            a = b; it = nx;
#pragma unroll
            for (int i = 0; i < 32; ++i) wa[i] = wb[i]; }
    }
}
__device__ __forceinline__ void conv_experts(const float* w1, const float* w3, const float* w2, int l, bf16_t* WE13, bf16_t* WE2, LAS float* scr, int gw, int ngw, int lane) {
    conv_range(w1, w3, w2, l, (unsigned char*)WE13, (unsigned char*)WE2, scr, gw, ngw, 0, CV_TOT, lane);
}
typedef const __attribute__((address_space(4))) char* kptr_t0;
#define KIN(i) (*(const float* const __attribute__((address_space(4)))*)(kp + 8 * (i)))
__device__ __forceinline__ void ph_convert_misc(kptr_t0 kp, unsigned char* ws, LAS float* scr, int gw, int ngw, int lane, int gtid, int ngt) {
    constexpr int I_ABIN = 32 * 96, I_SQ = 32 * 64, I_CDIN = 32 * 160, I_SH = 32 * 16, I_RT = 32 * 2, I_SH2 = 8 * 64, I_PL = 4 * 8;
    constexpr int TOT = I_ABIN + I_SQ + I_CDIN + I_SQ + 2 * (2 * I_SH + I_RT + I_SH2) + 4 * I_PL;
    for (int it = gw; it < TOT; it += ngw) {
        int r = it;
        if (r < I_ABIN) { if ((r % 96) < 64) { const int kb = r / 96, nb = r % 96; conv_item8(KIN(I_ABWIN), 3072, 64 * kb, 32 * nb, ws + WS_WABIN + (size_t)(32 * nb) * DM, DM, scr, lane); } continue; } r -= I_ABIN;
        if (r < I_SQ) { const int kb = r / 64, nb = r % 64; conv_item8(KIN(I_ABWOUT), DM, 64 * kb, 32 * nb, ws + WS_WABOUT + (size_t)(32 * nb) * DM, DM, scr, lane); continue; } r -= I_SQ;
        if (r < I_CDIN) {
            const int nblk = 5120 / 32, kb = r / nblk, n0 = 32 * (r % nblk); int drow = n0;
            if (n0 >= 1024) { const int base = n0 < 3072 ? 1024 : 3072, rel = n0 - base, seg = rel >> 10, c = rel & 1023; drow = base + (c >> 7) * 256 + seg * 128 + (c & 127); }
            conv_item8(KIN(I_CDWIN), 5120, 64 * kb, n0, ws + WS_WCDIN + (size_t)drow * DM, DM, scr, lane); continue; } r -= I_CDIN;
        if (r < I_SQ) { const int kb = r / 64, nb = r % 64; conv_item8(KIN(I_CDWOUT), DM, 64 * kb, 32 * nb, ws + WS_WCDOUT + (size_t)(32 * nb) * DM, DM, scr, lane); continue; } r -= I_SQ;
        bool done = false;
#pragma unroll
        for (int l = 0; l < 2; ++l) {
            if (done) break;
            bf16_t* sh1 = (bf16_t*)(ws + WS_WSH1) + (size_t)l * 1280 * DM; bf16_t* sh2 = (bf16_t*)(ws + WS_WSH2) + (size_t)l * DM * SFF;
            if (r < I_SH) { conv_gated8(KIN(I_SW1) + (size_t)l * DM * SFF, DM, SFF, ws + WS_WSH1F8 + (size_t)l * 1024 * DM, 0, r, scr, lane); done = true; break; } r -= I_SH;
            if (r < I_SH) { conv_gated8(KIN(I_SW3) + (size_t)l * DM * SFF, DM, SFF, ws + WS_WSH1F8 + (size_t)l * 1024 * DM, 1, r, scr, lane); done = true; break; } r -= I_SH;
            if (r < I_RT) { conv_plain(KIN(I_RW) + (size_t)l * DM * NE, DM, NE, sh1 + (size_t)1024 * DM, r, scr, lane); done = true; break; } r -= I_RT;
            if (r < I_SH2) { const int nblk = DM / 32, kb = r / nblk, nb = r % nblk; conv_item8(KIN(I_SW2) + (size_t)l * SFF * DM, DM, 64 * kb, 32 * nb, ws + WS_WSH2F8 + (size_t)l * DM * SFF + (size_t)(32 * nb) * SFF, SFF, scr, lane); done = true; break; } r -= I_SH2;
        }
        if (done) continue;
        { const int g = r / I_PL; conv_plain(KIN(I_POOLW) + (size_t)g * 65536, 256, 256, (bf16_t*)(ws + WS_WPOOL) + (size_t)g * 65536, r % I_PL, scr, lane); }
    }
    for (int i = gtid; i < 2 * 192 * DM / 8; i += ngt) { const int l = i / (192 * DM / 8), o = i % (192 * DM / 8);
        *(u32x4*)((bf16_t*)(ws + WS_WSH1) + (size_t)l * 1280 * DM + (size_t)1088 * DM + (size_t)o * 8) = (u32x4){0u, 0u, 0u, 0u}; }
    for (int i = gtid; i < 8 * 128 * 128 / 2; i += ngt) { const int e0 = i * 2, ii = (e0 >> 7) & 127, jj = e0 & 127; const bool ok = (ii >> 6) >= (jj >> 6);
        const f32x2 v = *(const f32x2*)(KIN(I_SGUW) + e0); ((unsigned*)(ws + WS_WSGU))[i] = ok ? cvt_pk_bf16(v.x, v.y) : 0u; }
}
__device__ __forceinline__ void ph_fold_pool(const float* w_in, const float* pool_w, const float* pool_scale, unsigned char* WT, LAS unsigned char* lds, int blk, int nblk, const int tid) {
    const int wave = __builtin_amdgcn_readfirstlane(tid >> 6), lane = tid & 63, r16 = lane & 15, grp = lane >> 4;
    for (int task = blk; task < 4 * 64; task += nblk) { const int g = task >> 6, k0 = (task & 63) * 32, d0 = wave * 32;
        f32x4 acc[2][2];
#pragma unroll
        for (int it = 0; it < 2; ++it)
#pragma unroll
            for (int jt = 0; jt < 2; ++jt) acc[it][jt] = (f32x4){0.f, 0.f, 0.f, 0.f};
#pragma unroll 2
        for (int cs = 0; cs < 8; ++cs) { const int c0 = cs * 32 + 8 * grp;
            bf16x8 af[2], bf[2];
#pragma unroll
            for (int it = 0; it < 2; ++it) { const float* ap = w_in + (size_t)(k0 + it * 16 + r16) * 3072 + 2048 + g * 256 + c0;
                const f32x4 a0 = *(const f32x4*)ap, a1 = *(const f32x4*)(ap + 4);
                u32x4 u; u.x = cvt_pk_bf16(a0[0], a0[1]); u.y = cvt_pk_bf16(a0[2], a0[3]); u.z = cvt_pk_bf16(a1[0], a1[1]); u.w = cvt_pk_bf16(a1[2], a1[3]); af[it] = __builtin_bit_cast(bf16x8, u); }
#pragma unroll
            for (int jt = 0; jt < 2; ++jt) { const float* bp = pool_w + (size_t)g * 65536 + (size_t)c0 * 256 + d0 + jt * 16 + r16;
                float b[8];
#pragma unroll
                for (int e = 0; e < 8; ++e) b[e] = bp[(size_t)e * 256];
                u32x4 u; u.x = cvt_pk_bf16(b[0], b[1]); u.y = cvt_pk_bf16(b[2], b[3]); u.z = cvt_pk_bf16(b[4], b[5]); u.w = cvt_pk_bf16(b[6], b[7]); bf[jt] = __builtin_bit_cast(bf16x8, u); }
#pragma unroll
            for (int it = 0; it < 2; ++it)
#pragma unroll
                for (int jt = 0; jt < 2; ++jt) acc[it][jt] = __builtin_amdgcn_mfma_f32_16x16x32_bf16(af[it], bf[jt], acc[it][jt], 0, 0, 0);
        }
#pragma unroll
        for (int jt = 0; jt < 2; ++jt) { const int d = d0 + jt * 16 + r16; const float sc = pool_scale[g * 256 + d] * W8_SCALE;
#pragma unroll
            for (int it = 0; it < 2; ++it)
                *(unsigned*)(WT + (size_t)(2048 + g * 256 + d) * DM + k0 + it * 16 + 4 * grp) = pg8::pk4_fp8(acc[it][jt][0] * sc, acc[it][jt][1] * sc, acc[it][jt][2] * sc, acc[it][jt][3] * sc); }
    }
}
__device__ __forceinline__ void ph_norm(const float* x, const float* g, const float* sc1p, const float* sh, unsigned char* h8, int gw, int ngw, int lane) {
    for (int row0 = gw * 4; row0 < NTOK; row0 += ngw * 4) {
        const int b = row0 >> 11;
        const f32x4* g4 = (const f32x4*)g + lane; const f32x4* s4 = (const f32x4*)(sc1p + (size_t)b * DM) + lane; const f32x4* h4 = (const f32x4*)(sh + (size_t)b * DM) + lane;
        f32x4 v[4][8]; float ss[4];
#pragma unroll
        for (int r = 0; r < 4; ++r) { const f32x4* xr = (const f32x4*)(x + (size_t)(row0 + r) * DM) + lane;
#pragma unroll
            for (int j = 0; j < 8; ++j) v[r][j] = xr[64 * j]; }
#pragma unroll
        for (int r = 0; r < 4; ++r) { float a = 0.f;
#pragma unroll
            for (int j = 0; j < 8; ++j) a += (v[r][j][0] * v[r][j][0] + v[r][j][1] * v[r][j][1]) + (v[r][j][2] * v[r][j][2] + v[r][j][3] * v[r][j][3]);
            ss[r] = a; }
#pragma unroll
        for (int r = 0; r < 4; ++r) ss[r] = wave_sum(ss[r], lane);
        float rstd[4];
#pragma unroll
        for (int r = 0; r < 4; ++r) rstd[r] = __builtin_amdgcn_rsqf(ss[r] * (1.0f / DM) + EPS);
#pragma unroll
        for (int j = 0; j < 8; ++j) { const f32x4 gs = g4[64 * j] * s4[64 * j], hh = h4[64 * j];
#pragma unroll
            for (int r = 0; r < 4; ++r) { const f32x4 o4 = v[r][j] * rstd[r] * gs + hh;
                ((unsigned*)(h8 + (size_t)(row0 + r) * DM) + lane)[64 * j] = pg8::pk4_fp8(o4[0], o4[1], o4[2], o4[3]); } }
    }
}
__device__ __forceinline__ void ph_final_norm(float* x, const float* g, int gw, int ngw, int lane) {
    for (int row = gw; row < NTOK; row += ngw) {
        f32x4* xr = (f32x4*)(x + (size_t)row * DM) + lane;
        f32x4 v[8]; float ss = 0.f;
#pragma unroll
        for (int j = 0; j < 8; ++j) { v[j] = xr[64 * j]; ss += (v[j][0] * v[j][0] + v[j][1] * v[j][1]) + (v[j][2] * v[j][2] + v[j][3] * v[j][3]); }
        const float rstd = __builtin_amdgcn_rsqf(wave_sum(ss, lane) * (1.0f / DM) + EPS);
        const f32x4* g4 = (const f32x4*)g + lane;
#pragma unroll
        for (int j = 0; j < 8; ++j) xr[64 * j] = v[j] * rstd * g4[64 * j];
    }
}

template <int N> struct RsStep {
    static __device__ __forceinline__ float run(const float (&v)[N], int lane) {
        constexpr int H = N / 2; float nv[H]; const bool up = (lane & H) != 0;
#pragma unroll
        for (int i = 0; i < H; ++i) { const float send = up ? v[i] : v[i + H], keep = up ? v[i + H] : v[i]; nv[i] = keep + shfl_xor_l(send, H, lane); }
        return RsStep<H>::run(nv, lane);
    }
};
template <> struct RsStep<1> { static __device__ __forceinline__ float run(const float (&v)[1], int) { return v[0]; } };
template <int NV> __device__ __forceinline__ void reduce_scatter(float (&v)[NV], int lane) {
#pragma unroll
    for (int off = 32; off >= NV; off >>= 1) {
#pragma unroll
        for (int i = 0; i < NV; ++i) v[i] += shfl_xor_l(v[i], off, lane); }
    v[0] = RsStep<NV>::run(v, lane);
}

constexpr int VP = 272;
constexpr int MX_V = 0, MX_VBUF = 34816, MX_STAT = 69632, MX_LN = 70656;
constexpr int XP = 512, AP = 528;
constexpr int MX_X = 0, MX_A = 40960;
__device__ __forceinline__ void ph_mixer_ab(const bf16_t* P, unsigned char* Y, const bf16_t* Wsgu, const float* sgu_b, const float* ln_g, const float* ln_b, const bf16_t* Wpool, const float* pool_scale,
                                            LAS unsigned char* lds, int blk, int nblk, const int tid) {
    const int w = __builtin_amdgcn_readfirstlane(tid >> 6), lane = tid & 63, fr = lane & 15, fq = lane >> 4;
    LAS f32x2* stat = (LAS f32x2*)(lds + MX_STAT);
    LAS float* lng = (LAS float*)(lds + MX_LN); LAS float* lnb = lng + 1024;
    *(LAS f32x2*)(lng + 2 * tid) = *(const f32x2*)(ln_g + 2 * tid); *(LAS f32x2*)(lnb + 2 * tid) = *(const f32x2*)(ln_b + 2 * tid);
    for (int unit = blk; unit < NTOK / 128; unit += nblk) {
        const int tok0 = unit * 128, pos0 = tok0 & (SEQ - 1);
#pragma unroll 1
        for (int i0 = 0; i0 < 16; i0 += 8) {
            float sv[16];
#pragma unroll
            for (int i = 0; i < 8; ++i) { const u32x4* vr = (const u32x4*)(P + (size_t)(tok0 + w * 16 + i0 + i) * 3072 + 1024);
                float sa = 0.f, qa = 0.f;
#pragma unroll
                for (int j = 0; j < 2; ++j) { const u32x4 x = vr[lane + 64 * j];
#pragma unroll
                    for (int e = 0; e < 4; ++e) { const float a = bf_lo(x[e]), b = bf_hi(x[e]); sa += a + b; qa += a * a + b * b; } }
                sv[2 * i] = sa; sv[2 * i + 1] = qa; }
            reduce_scatter<16>(sv, lane);
            const float other = shfl_xor_l(sv[0], 1, lane);
            if ((lane & 1) == 0 && lane < 16) { const float mean = sv[0] * (1.0f / 1024.0f), var = fmaxf(other * (1.0f / 1024.0f) - mean * mean, 0.f);
                stat[w * 16 + i0 + (lane >> 1)] = (f32x2){mean, __builtin_amdgcn_rsqf(var + EPS)}; }
        }
        __syncthreads();
        u32x4 vn[4];
#pragma unroll
        for (int j = 0; j < 4; ++j) { const int q = tid + 512 * j, t = q >> 4, c8 = q & 15; vn[j] = *(const u32x4*)(P + (size_t)(tok0 + t) * 3072 + 1024 + c8 * 8); }
        bf16x8 wsn[4]; u32x2 un[8]; float bn;
        { const int t = 16 * w + fr;
#pragma unroll
          for (int ks = 0; ks < 4; ++ks) wsn[ks] = *(const bf16x8*)(Wsgu + ((size_t)(16 * w + fr)) * 128 + 32 * ks + 8 * fq);
          bn = sgu_b[t];
#pragma unroll
          for (int c = 0; c < 8; ++c) un[c] = *(const u32x2*)(P + (size_t)(tok0 + t) * 3072 + 4 * fq + 16 * c); }
#pragma unroll 1
        for (int h = 0; h < 8; ++h) {
            LAS unsigned char* vb = lds + MX_V + (h & 1) * MX_VBUF;
#pragma unroll
            for (int j = 0; j < 4; ++j) { const int q = tid + 512 * j, t = q >> 4, c8 = q & 15;
                const f32x2 st = stat[t];
                const f32x4 g0 = *(const LAS f32x4*)(lng + h * 128 + c8 * 8), g1 = *(const LAS f32x4*)(lng + h * 128 + c8 * 8 + 4);
                const f32x4 b0 = *(const LAS f32x4*)(lnb + h * 128 + c8 * 8), b1 = *(const LAS f32x4*)(lnb + h * 128 + c8 * 8 + 4);
                float r[8];
#pragma unroll
                for (int e = 0; e < 4; ++e) { r[2 * e] = bf_lo(vn[j][e]); r[2 * e + 1] = bf_hi(vn[j][e]); }
#pragma unroll
                for (int e = 0; e < 4; ++e) { r[e] = (r[e] - st.x) * st.y * g0[e] + b0[e]; r[4 + e] = (r[4 + e] - st.x) * st.y * g1[e] + b1[e]; }
                u32x4 o; o.x = cvt_pk_bf16(r[0], r[1]); o.y = cvt_pk_bf16(r[2], r[3]); o.z = cvt_pk_bf16(r[4], r[5]); o.w = cvt_pk_bf16(r[6], r[7]);
                *(LAS u32x4*)(vb + t * VP + c8 * 16) = o; }
            __syncthreads();
            if (h < 7) {
#pragma unroll
                for (int j = 0; j < 4; ++j) { const int q = tid + 512 * j, t = q >> 4, c8 = q & 15; vn[j] = *(const u32x4*)(P + (size_t)(tok0 + t) * 3072 + 1024 + (h + 1) * 128 + c8 * 8); } }
            bf16x8 wsf[4]; u32x2 uv[8];
#pragma unroll
            for (int ks = 0; ks < 4; ++ks) wsf[ks] = wsn[ks];
#pragma unroll
            for (int c = 0; c < 8; ++c) uv[c] = un[c];
            const int t = 16 * w + fr; const float bias = bn;
            unsigned char* yp = Y + (size_t)(tok0 + t) * DM + h * 128 + 4 * fq;
            if (h < 7) {
#pragma unroll
                for (int ks = 0; ks < 4; ++ks) wsn[ks] = *(const bf16x8*)(Wsgu + ((size_t)((h + 1) * 128 + 16 * w + fr)) * 128 + 32 * ks + 8 * fq);
                bn = sgu_b[(h + 1) * 128 + t];
#pragma unroll
                for (int c = 0; c < 8; ++c) un[c] = *(const u32x2*)(P + (size_t)(tok0 + t) * 3072 + (h + 1) * 128 + 4 * fq + 16 * c); }
            f32x4 acc[8];
#pragma unroll
            for (int c = 0; c < 8; ++c) acc[c] = (f32x4){0.f, 0.f, 0.f, 0.f};
            const int q4 = fr >> 2, p4 = fr & 3;
#pragma unroll
            for (int c = 0; c < 8; ++c)
#pragma unroll
                for (int ks = 0; ks < 4; ++ks) {
                    const LAS unsigned char* a0 = vb + (32 * ks + 8 * fq + q4) * VP + (16 * c + 4 * p4) * 2;
                    const bf16x4 lo = __builtin_amdgcn_ds_read_tr16_b64_v4i16((LAS bf16x4*)a0);
                    const bf16x4 hi = __builtin_amdgcn_ds_read_tr16_b64_v4i16((LAS bf16x4*)(a0 + 4 * VP));
                    const bf16x8 vf = __builtin_shufflevector(lo, hi, 0, 1, 2, 3, 4, 5, 6, 7);
                    acc[c] = __builtin_amdgcn_mfma_f32_16x16x32_bf16(vf, wsf[ks], acc[c], 0, 0, 0);
                }
#pragma unroll
            for (int c = 0; c < 8; ++c) { const u32x2 u = uv[c];
                *(unsigned*)(yp + 16 * c) = pg8::pk4_fp8c(bf_lo(u.x) * (acc[c][0] + bias), bf_hi(u.x) * (acc[c][1] + bias), bf_lo(u.y) * (acc[c][2] + bias), bf_hi(u.y) * (acc[c][3] + bias)); }
        }
        __syncthreads();
        { const int co = tid & 127, tq = tid >> 7, win = 2 << (co >> 5), pos = pos0 + tq * 32;
          const bf16_t* qp = P + (size_t)(tok0 + tq * 32) * 3072 + 2048 + co * 8; unsigned char* yp = Y + (size_t)(tok0 + tq * 32) * DM + 1024 + co * 8;
          float run[8];
#pragma unroll
          for (int e = 0; e < 8; ++e) run[e] = 0.f;
          { u32x4 xi[15];
#pragma unroll
            for (int d = 1; d < 16; ++d) { const bool ok = (d < win) && (pos - d >= 0); const u32x4 x = *(const u32x4*)(qp - (size_t)(ok ? d : 0) * 3072); xi[d - 1] = ok ? x : (u32x4){0u, 0u, 0u, 0u}; }
#pragma unroll
            for (int d = 0; d < 15; ++d)
#pragma unroll
                for (int e = 0; e < 4; ++e) { run[2 * e] += bf_lo(xi[d][e]); run[2 * e + 1] += bf_hi(xi[d][e]); } }
#pragma unroll 1
          for (int tb = 0; tb < 32; tb += 8) {
              u32x4 xin[8], xout[8];
#pragma unroll
              for (int k = 0; k < 8; ++k) { xin[k] = *(const u32x4*)(qp + (size_t)(tb + k) * 3072);
                  const int lo = tb + k + 1 - win; const bool ok = pos + lo >= 0; const u32x4 y = *(const u32x4*)(qp + (long)(ok ? lo : 0) * 3072); xout[k] = ok ? y : (u32x4){0u, 0u, 0u, 0u}; }
#pragma unroll
              for (int k = 0; k < 8; ++k) { float xv[8], r[8];
#pragma unroll
                  for (int e = 0; e < 4; ++e) { xv[2 * e] = bf_lo(xin[k][e]); xv[2 * e + 1] = bf_hi(xin[k][e]); }
                  const int pk = pos + tb + k; const float inv = 1.0f / (float)((pk + 1) < win ? (pk + 1) : win);
#pragma unroll
                  for (int e = 0; e < 8; ++e) { run[e] += xv[e]; r[e] = run[e] * inv - xv[e]; }
                  u32x2 o; o.x = pg8::pk4_fp8c(r[0], r[1], r[2], r[3]); o.y = pg8::pk4_fp8c(r[4], r[5], r[6], r[7]);
                  *(u32x2*)(yp + (size_t)(tb + k) * DM) = o;
#pragma unroll
                  for (int e = 0; e < 4; ++e) { run[2 * e] -= bf_lo(xout[k][e]); run[2 * e + 1] -= bf_hi(xout[k][e]); } } } }
        __syncthreads();
    }
}

constexpr int CD_T = 32, CD_H = 30, CD_ROWS = CD_T + CD_H;
constexpr int CD_RED = (CD_ROWS + 1) * 2048, CD_STAT = MISC_OFF + 1024;
__device__ __forceinline__ void ph_mixer_cd(const bf16_t* P, unsigned char* Y, const float* c3w, const float* c3b, const float* c31w, const float* c31b, const float* ln_g, const float* ln_b,
                                            LAS unsigned char* lds, int blk, int nblk, const int tid) {
    const int w = __builtin_amdgcn_readfirstlane(tid >> 6), lane = tid & 63;
    LAS float* red = (LAS float*)(lds + CD_RED); LAS f32x2* stat = (LAS f32x2*)(lds + CD_STAT);
    const int c0 = 2 * tid;
    for (int unit = blk; unit < NTOK / CD_T; unit += nblk) {
        const int tok0 = unit * CD_T, pos0 = tok0 & (SEQ - 1);
#pragma unroll 1
        for (int jb = 0; jb < 16; jb += 8) {
            u32x4 av[8];
#pragma unroll
            for (int j = 0; j < 8; ++j) { const int q = tid + 512 * (jb + j), r = q >> 7, c8 = q & 127; const bool ok = (r < CD_ROWS) && (pos0 - CD_H + r >= 0);
                av[j] = *(const u32x4*)(P + (size_t)(tok0 + (ok ? r - CD_H : 0)) * 3072 + 2048 + c8 * 8); }
#pragma unroll
            for (int j = 0; j < 8; ++j) { const int q = tid + 512 * (jb + j), r = q >> 7, c8 = q & 127; const bool ok = (r < CD_ROWS) && (pos0 - CD_H + r >= 0);
                if (r <= CD_ROWS) *(LAS u32x4*)(lds + r * 2048 + c8 * 16) = ok ? av[j] : (u32x4){0u, 0u, 0u, 0u}; }
        }
        __syncthreads();
        f32x2 acc[CD_T];
        { const f32x2 bb = *(const f32x2*)(c31b + c0);
#pragma unroll
          for (int t = 0; t < CD_T; ++t) acc[t] = bb; }
        f32x2 wkn[4];
#pragma unroll
        for (int k = 0; k < 4; ++k) wkn[k] = *(const f32x2*)(c31w + k * 1024 + c0);
#pragma unroll 1
        for (int kb = 0; kb < 8; ++kb) {
            f32x2 wk[4];
#pragma unroll
            for (int k = 0; k < 4; ++k) wk[k] = wkn[k];
            if (kb < 7) {
#pragma unroll
                for (int k = 0; k < 4; ++k) { const int kk = 4 * (kb + 1) + k; wkn[k] = (f32x2){0.f, 0.f}; if (kk < 31) wkn[k] = *(const f32x2*)(c31w + kk * 1024 + c0); } }
            f32x2 dv[CD_T + 3];
#pragma unroll
            for (int i = 0; i < CD_T + 3; ++i) { const unsigned d = *(const LAS unsigned*)(lds + (4 * kb + i) * 2048 + tid * 4); dv[i] = (f32x2){bf_lo(d), bf_hi(d)}; }
#pragma unroll
            for (int k = 0; k < 4; ++k)
#pragma unroll
                for (int t = 0; t < CD_T; ++t) acc[t] += wk[k] * dv[t + k];
        }
        { float sv[64];
#pragma unroll
          for (int t = 0; t < CD_T; ++t) { sv[2 * t] = acc[t].x + acc[t].y; sv[2 * t + 1] = acc[t].x * acc[t].x + acc[t].y * acc[t].y; }
          reduce_scatter<64>(sv, lane);
          red[w * 64 + lane] = sv[0]; }
        __syncthreads();
        if (tid < CD_T) { float sa = 0.f, qa = 0.f;
#pragma unroll
            for (int ww = 0; ww < 8; ++ww) { sa += red[ww * 64 + 2 * tid]; qa += red[ww * 64 + 2 * tid + 1]; }
            const float mean = sa * (1.0f / 1024.0f), var = fmaxf(qa * (1.0f / 1024.0f) - mean * mean, 0.f);
            stat[tid] = (f32x2){mean, __builtin_amdgcn_rsqf(var + EPS)}; }
        __syncthreads();
        { const f32x2 gg = *(const f32x2*)(ln_g + c0), bb = *(const f32x2*)(ln_b + c0);
#pragma unroll
          for (int t = 0; t < CD_T; ++t) { const f32x2 st = stat[t];
              const float a = (acc[t].x - st.x) * st.y * gg.x + bb.x, b = (acc[t].y - st.x) * st.y * gg.y + bb.y;
              *(unsigned short*)(Y + (size_t)(tok0 + t) * DM + 1024 + c0) = (unsigned short)__builtin_amdgcn_cvt_pk_fp8_f32(pg8::clamp8(fast_silu(a) * pg8::Y8M_SCALE), pg8::clamp8(fast_silu(b) * pg8::Y8M_SCALE), 0, false); } }
        { const int c8 = tid & 127, tg = tid >> 7, cc = c8 * 8, t0 = tg * 8;
          const f32x4 w0a = *(const f32x4*)(c3w + cc), w0b = *(const f32x4*)(c3w + cc + 4), w1a = *(const f32x4*)(c3w + 1024 + cc), w1b = *(const f32x4*)(c3w + 1024 + cc + 4);
          const f32x4 w2a = *(const f32x4*)(c3w + 2048 + cc), w2b = *(const f32x4*)(c3w + 2048 + cc + 4), bba = *(const f32x4*)(c3b + cc), bbb = *(const f32x4*)(c3b + cc + 4);
          float wv0[8], wv1[8], wv2[8], bv[8];
#pragma unroll
          for (int e = 0; e < 4; ++e) { wv0[e] = w0a[e]; wv0[4 + e] = w0b[e]; wv1[e] = w1a[e]; wv1[4 + e] = w1b[e]; wv2[e] = w2a[e]; wv2[4 + e] = w2b[e]; bv[e] = bba[e]; bv[4 + e] = bbb[e]; }
          u32x4 zv[10], bgv[8];
#pragma unroll
          for (int i = 0; i < 10; ++i) { const bool ok = pos0 + t0 + i - 2 >= 0; const u32x4 a = *(const u32x4*)(P + (size_t)(tok0 + (ok ? t0 + i - 2 : 0)) * 3072 + 1024 + cc); zv[i] = ok ? a : (u32x4){0u, 0u, 0u, 0u}; }
#pragma unroll
          for (int i = 0; i < 8; ++i) bgv[i] = *(const u32x4*)(P + (size_t)(tok0 + t0 + i) * 3072 + cc);
          float z0[8], z1[8];
#pragma unroll
          for (int e = 0; e < 4; ++e) { z0[2 * e] = bf_lo(zv[0][e]); z0[2 * e + 1] = bf_hi(zv[0][e]); z1[2 * e] = bf_lo(zv[1][e]); z1[2 * e + 1] = bf_hi(zv[1][e]); }
#pragma unroll
          for (int i = 0; i < 8; ++i) { float z2[8], r[8];
#pragma unroll
              for (int e = 0; e < 4; ++e) { z2[2 * e] = bf_lo(zv[i + 2][e]); z2[2 * e + 1] = bf_hi(zv[i + 2][e]); }
#pragma unroll
              for (int e = 0; e < 4; ++e) { r[2 * e] = bf_lo(bgv[i][e]) * (bv[2 * e] + wv0[2 * e] * z0[2 * e] + wv1[2 * e] * z1[2 * e] + wv2[2 * e] * z2[2 * e]);
                  r[2 * e + 1] = bf_hi(bgv[i][e]) * (bv[2 * e + 1] + wv0[2 * e + 1] * z0[2 * e + 1] + wv1[2 * e + 1] * z1[2 * e + 1] + wv2[2 * e + 1] * z2[2 * e + 1]); }
              u32x2 o; o.x = pg8::pk4_fp8c(r[0], r[1], r[2], r[3]); o.y = pg8::pk4_fp8c(r[4], r[5], r[6], r[7]);
              *(u32x2*)(Y + (size_t)(tok0 + t0 + i) * DM + cc) = o;
#pragma unroll
              for (int e = 0; e < 8; ++e) { z0[e] = z1[e]; z1[e] = z2[e]; } } }
        __syncthreads();
    }
}

__device__ __forceinline__ void ph_route(const float* logits, const float* rbias, unsigned* gcnt, int* ts_e, int* ts_r, float* ts_w, LAS unsigned char* lds, int blk, int nblk, const int tid) {
    const int w = __builtin_amdgcn_readfirstlane(tid >> 6), lane = tid & 63;
    LAS unsigned* lcnt = (LAS unsigned*)lds; LAS unsigned* lbase = lcnt + 64; LAS unsigned* rec = lcnt + 128;
    const float rb = rbias[lane];
    for (int chunk = blk; chunk < NTOK / 128; chunk += nblk) {
        if (tid < 64) lcnt[tid] = 0u;
        __syncthreads();
        for (int i = 0; i < 16; ++i) { const int tl = w * 16 + i, tok = chunk * 128 + tl;
            const float score = 1.0f / (1.0f + __expf(-logits[(size_t)tok * NE + lane])), choice = score + rb;
            float m1 = choice, m2 = -INFINITY;
#pragma unroll
            for (int o = 1; o < 8; o <<= 1) { const float o1 = o == 1 ? dpp_f<0xB1>(m1, m1) : o == 2 ? dpp_f<0x4E>(m1, m1) : dpp_f<0x141>(m1, m1), o2 = o == 1 ? dpp_f<0xB1>(m2, m2) : o == 2 ? dpp_f<0x4E>(m2, m2) : dpp_f<0x141>(m2, m2);
                const float n1 = fmaxf(m1, o1), n2 = fmaxf(fminf(m1, o1), fmaxf(m2, o2)); m1 = n1; m2 = n2; }
            const float gs = m1 + m2; const int myg = lane >> 3; int grank = 0;
#pragma unroll
            for (int g = 0; g < 8; ++g) { const float s = rdlane(gs, g * 8); grank += (s > gs || (s == gs && g < myg)) ? 1 : 0; }
            const unsigned cb = __builtin_bit_cast(unsigned, choice), mono = (cb & 0x80000000u) ? ~cb : (cb | 0x80000000u);
            const unsigned key = grank < 4 ? ((mono & ~63u) | (unsigned)(63 - lane)) : 0u;
            int rank = 0;
#pragma unroll
            for (int j = 0; j < 64; ++j) { const unsigned kj = (unsigned)__builtin_amdgcn_readlane((int)key, j); rank += (kj > key) ? 1 : 0; }
            const bool sel = rank < TOPK;
            const float wsum = wave_sum(sel ? score : 0.f, lane);
            if (sel) { const unsigned lp = atomicAdd((unsigned*)&lcnt[lane], 1u); rec[tl * TOPK + rank] = (unsigned)lane | (lp << 8); ts_w[(size_t)tok * TOPK + rank] = score / wsum * 2.5f; } }
        __syncthreads();
        if (tid < 64) lbase[tid] = atomicAdd(&gcnt[tid], lcnt[tid]);
        __syncthreads();
        for (int q = tid; q < 128 * TOPK; q += 512) { const unsigned r = rec[q]; const int e = r & 255; const size_t ts = (size_t)chunk * 128 * TOPK + q; ts_e[ts] = e; ts_r[ts] = (int)(lbase[e] + (r >> 8)); }
        __syncthreads();
    }
}

__device__ __forceinline__ void ph_router_prep(const float* rw, const float* g2, const float* modf, bf16_t* WRS, float* CBP, int gtid, int ngt, int gw, int ngw, int lane) {
    for (int i = gtid; i < 2 * NB * NE * (DM / 8); i += ngt) {
        const int k0 = (i & 255) * 8, e = (i >> 8) & 63, b = (i >> 14) & 15, l = i >> 18;
        const float* rwp = rw + (size_t)l * DM * NE + (size_t)k0 * NE + e;
        const float* gp = g2 + l * DM + k0; const float* sp = modf + ((size_t)(l * 6 + 4) * NB + b) * DM + k0;
        const f32x4 ga = *(const f32x4*)gp * *(const f32x4*)sp, gb = *(const f32x4*)(gp + 4) * *(const f32x4*)(sp + 4);
        float v[8];
#pragma unroll
        for (int j = 0; j < 8; ++j) v[j] = rwp[(size_t)j * NE] * (j < 4 ? ga[j & 3] : gb[j & 3]);
        u32x4 o; o.x = cvt_pk_bf16(v[0], v[1]); o.y = cvt_pk_bf16(v[2], v[3]); o.z = cvt_pk_bf16(v[4], v[5]); o.w = cvt_pk_bf16(v[6], v[7]);
        *(u32x4*)(WRS + ((size_t)(l * NB + b) * NE + e) * DM + k0) = o;
    }
    for (int t = gw; t < 2 * NB * 8; t += ngw) { const int kq = t & 7, b = (t >> 3) & 15, l = t >> 7;
        const float* rwp = rw + (size_t)l * DM * NE + (size_t)(kq * 256) * NE + lane; const float* hp = modf + ((size_t)(l * 6 + 3) * NB + b) * DM + kq * 256;
        float s = 0.f;
#pragma unroll 8
        for (int k = 0; k < 256; ++k) s += hp[k] * rwp[(size_t)k * NE];
        CBP[(size_t)((l * NB + b) * 8 + kq) * NE + lane] = s; }
}
constexpr int NR_WR = 0, NR_PITCH = 1040;
constexpr int NR_LG = 69632;
constexpr int NR_CNT = 69632 + 32768;
constexpr int NR_RS = 110592;
__device__ __forceinline__ void ph_norm_route(const bf16_t* x, const float* g, const float* sc1p, const float* sh, const bf16_t* WRSl, const float* CBPl, const float* rbias, unsigned* gcnt,
                                              int* rowtok, int* rowdst, float* roww, LAS unsigned char* lds, int blk, int nblk, const int tid, const int mode, unsigned char* H8) {
    const int w = __builtin_amdgcn_readfirstlane(tid >> 6), lane = tid & 63, fr = lane & 15, fq = lane >> 4;
    LAS unsigned* lcnt = (LAS unsigned*)(lds + NR_CNT); LAS unsigned* lbase = lcnt + 64; LAS unsigned* rec = lcnt + 128; LAS float* recw = (LAS float*)(rec + 768);
    LAS float* lg = (LAS float*)(lds + NR_LG + w * 4096);
    LAS float* rs = (LAS float*)(lds + NR_RS) + w * 16; LAS float* cvec = (LAS float*)(lds + NR_RS + 512);
    const float rb = rbias[lane];
    for (int chunk = blk; chunk < NTOK / 128; chunk += nblk) {
        const int bch = (chunk * 128) >> 11;
        if (tid < 64) { lcnt[tid] = 0u; float c = 0.f;
#pragma unroll
            for (int kq = 0; kq < 8; ++kq) c += CBPl[(size_t)(bch * 8 + kq) * NE + tid];
            cvec[tid] = c; }
        const bf16_t* Wr = WRSl + (size_t)bch * NE * DM;
        const int row0 = chunk * 128 + w * 16;
        { const int b = row0 >> 11;
          const f32x4* g4 = (const f32x4*)g + lane; const f32x4* s4 = (const f32x4*)(sc1p + (size_t)b * DM) + lane; const f32x4* h4 = (const f32x4*)(sh + (size_t)b * DM) + lane;
#pragma unroll 1
          for (int i0 = 0; i0 < 16; i0 += 4) {
            u32x2 t[4][8]; float rstd[4];
#pragma unroll
            for (int r = 0; r < 4; ++r) { const u32x2* xr = (const u32x2*)(x + (size_t)(row0 + i0 + r) * DM) + lane;
#pragma unroll
                for (int j = 0; j < 8; ++j) t[r][j] = xr[64 * j]; }
#pragma unroll
            for (int r = 0; r < 4; ++r) { float a = 0.f;
#pragma unroll
                for (int j = 0; j < 8; ++j) { const float v0 = bf_lo(t[r][j].x), v1 = bf_hi(t[r][j].x), v2 = bf_lo(t[r][j].y), v3 = bf_hi(t[r][j].y); a += (v0 * v0 + v1 * v1) + (v2 * v2 + v3 * v3); }
                rstd[r] = __builtin_amdgcn_rsqf(wave_sum(a, lane) * (1.0f / DM) + EPS); if (lane == 0) rs[i0 + r] = rstd[r]; }
#pragma unroll
            for (int j = 0; j < 8; ++j) { const f32x4 gs = g4[64 * j] * s4[64 * j], hh = h4[64 * j];
#pragma unroll
                for (int r = 0; r < 4; ++r) { const f32x4 vv = (f32x4){bf_lo(t[r][j].x), bf_hi(t[r][j].x), bf_lo(t[r][j].y), bf_hi(t[r][j].y)}; const f32x4 o4 = vv * rstd[r] * gs + hh;
                    ((unsigned*)(H8 + (size_t)(row0 + i0 + r) * DM) + lane)[64 * j] = pg8::pk4_fp8(o4[0], o4[1], o4[2], o4[3]); } }
          } }
        if (PROBE_N > 0 && mode == 2) continue;
        f32x4 acc[4];
#pragma unroll
        for (int nt = 0; nt < 4; ++nt) acc[nt] = (f32x4){0.f, 0.f, 0.f, 0.f};
#pragma unroll 1
        for (int kq = 0; kq < 4; ++kq) {
            bf16x8 hf[16];
#pragma unroll
            for (int ks = 0; ks < 16; ++ks) hf[ks] = *(const bf16x8*)(x + (size_t)(row0 + fr) * DM + kq * 512 + 32 * ks + 8 * fq);
            __syncthreads();
#pragma unroll
            for (int j = 0; j < 8; ++j) { const int q = tid + 512 * j, e = q >> 6, c8 = q & 63;
                *(LAS u32x4*)(lds + NR_WR + e * NR_PITCH + c8 * 16) = *(const u32x4*)(Wr + (size_t)e * DM + kq * 512 + c8 * 8); }
            __syncthreads();
#pragma unroll
            for (int ks = 0; ks < 16; ++ks) {
#pragma unroll
                for (int nt = 0; nt < 4; ++nt) { const bf16x8 wf = *(const LAS bf16x8*)(lds + NR_WR + (16 * nt + fr) * NR_PITCH + (32 * ks + 8 * fq) * 2);
                    acc[nt] = __builtin_amdgcn_mfma_f32_16x16x32_bf16(wf, hf[ks], acc[nt], 0, 0, 0); }
            }
        }
        { const float rsv = rs[fr];
#pragma unroll
          for (int nt = 0; nt < 4; ++nt) *(LAS f32x4*)(lg + fr * 64 + 16 * nt + 4 * fq) = acc[nt] * rsv + *(const LAS f32x4*)(cvec + 16 * nt + 4 * fq); }
        LDS_WAIT();
        if (PROBE_N > 0 && mode == 3) continue;
        for (int i = 0; i < 16; ++i) { const int tl = w * 16 + i, tok = chunk * 128 + tl;
            const float score = 1.0f / (1.0f + __expf(-lg[i * 64 + lane])), choice = score + rb;
            float m1 = choice, m2 = -INFINITY;
#pragma unroll
            for (int o = 1; o < 8; o <<= 1) { const float o1 = o == 1 ? dpp_f<0xB1>(m1, m1) : o == 2 ? dpp_f<0x4E>(m1, m1) : dpp_f<0x141>(m1, m1), o2 = o == 1 ? dpp_f<0xB1>(m2, m2) : o == 2 ? dpp_f<0x4E>(m2, m2) : dpp_f<0x141>(m2, m2);
                const float n1 = fmaxf(m1, o1), n2 = fmaxf(fminf(m1, o1), fmaxf(m2, o2)); m1 = n1; m2 = n2; }
            const float gs = m1 + m2; const int myg = lane >> 3; int grank = 0;
#pragma unroll
            for (int gq = 0; gq < 8; ++gq) { const float sv = rdlane(gs, gq * 8); grank += (sv > gs || (sv == gs && gq < myg)) ? 1 : 0; }
            const float masked = grank < 4 ? choice : -INFINITY;
            unsigned long long selm = 0ull; float cur = masked;
#pragma unroll
            for (int r = 0; r < TOPK; ++r) { const float mx = wave_max(cur); const unsigned long long eq = __builtin_amdgcn_ballot_w64(cur == mx); const int idx = __builtin_ctzll(eq);
                selm |= 1ull << idx; cur = (lane == idx) ? -INFINITY : cur; }
            const bool sel = ((selm >> lane) & 1ull) != 0ull;
            const int rank = (int)__builtin_amdgcn_mbcnt_hi((unsigned)(selm >> 32), __builtin_amdgcn_mbcnt_lo((unsigned)selm, 0u));
            const float wsum = wave_sum(sel ? score : 0.f, lane);
            if (sel) { const unsigned lp = atomicAdd((unsigned*)&lcnt[lane], 1u); rec[tl * TOPK + rank] = (unsigned)lane | (lp << 8); recw[tl * TOPK + rank] = score / wsum * 2.5f; } }
        __syncthreads();
        if (tid < 64) lbase[tid] = atomicAdd(&gcnt[tid], lcnt[tid]);
        __syncthreads();
        for (int q = tid; q < 128 * TOPK; q += 512) { const unsigned r = rec[q]; const int e = r & 255; const unsigned pos = lbase[e] + (r >> 8);
            if (pos < (unsigned)ECAP) { const size_t row = (size_t)e * ECAP + pos; rowtok[row] = chunk * 128 + q / TOPK; rowdst[row] = chunk * 128 * TOPK + q; roww[row] = recw[q]; } }
        __syncthreads();
    }
}
template <bool LAST>
__device__ __forceinline__ void ph_combine_norm(const bf16_t* x, void* xo, const unsigned char* Y6, const unsigned char* shout, const float* gate, const float* gn, const float* scn, const float* shn, unsigned char* H8, int gw, int ngw, int lane) {
    for (int row = gw; row < NTOK; row += ngw) {
        const int b = row >> 11;
        const bf16_t* xr = x + (size_t)row * DM; const unsigned char* yr = Y6 + (size_t)row * (TOPK * DM); const unsigned char* sr = shout + (size_t)row * DM; const float* gr = gate + (size_t)b * DM;
        float v[2][16]; float ss = 0.f;
        u32x4 yv[2][TOPK + 1], xv[2][2];
#pragma unroll
        for (int j = 0; j < 2; ++j) { const int c = 16 * (lane + 64 * j);
#pragma unroll
            for (int k = 0; k < TOPK; ++k) yv[j][k] = *(const u32x4*)(yr + (size_t)k * DM + c);
            yv[j][TOPK] = *(const u32x4*)(sr + c); xv[j][0] = *(const u32x4*)(xr + c); xv[j][1] = *(const u32x4*)(xr + c + 8); }
        asm volatile("" ::: "memory");
#pragma unroll
        for (int j = 0; j < 2; ++j) { const int c = 16 * (lane + 64 * j);
            float m[16];
#pragma unroll
            for (int e = 0; e < 16; ++e) m[e] = 0.f;
#pragma unroll
            for (int k = 0; k < TOPK + 1; ++k) { const u32x4 t = yv[j][k];
#pragma unroll
                for (int e = 0; e < 4; ++e) { const f32x2 lo = __builtin_amdgcn_cvt_pk_f32_fp8((int)t[e], false), hi = __builtin_amdgcn_cvt_pk_f32_fp8((int)t[e], true);
                    m[4 * e] += lo.x; m[4 * e + 1] += lo.y; m[4 * e + 2] += hi.x; m[4 * e + 3] += hi.y; } }
#pragma unroll
            for (int e = 0; e < 16; ++e) m[e] *= (1.0f / pg8::Y8_SCALE);
            { const u32x4 x0 = xv[j][0], x1 = xv[j][1]; float xf[16];
#pragma unroll
              for (int e = 0; e < 4; ++e) { xf[2 * e] = bf_lo(x0[e]); xf[2 * e + 1] = bf_hi(x0[e]); xf[8 + 2 * e] = bf_lo(x1[e]); xf[8 + 2 * e + 1] = bf_hi(x1[e]); }
#pragma unroll
              for (int q = 0; q < 4; ++q) { const f32x4 gv = *(const f32x4*)(gr + c + 4 * q);
#pragma unroll
                  for (int e = 0; e < 4; ++e) { v[j][4 * q + e] = xf[4 * q + e] + gv[e] * m[4 * q + e]; ss += v[j][4 * q + e] * v[j][4 * q + e]; } } }
            asm volatile("" : "+v"(v[j][0]), "+v"(v[j][1]), "+v"(v[j][2]), "+v"(v[j][3]), "+v"(v[j][4]), "+v"(v[j][5]), "+v"(v[j][6]), "+v"(v[j][7]),
                              "+v"(v[j][8]), "+v"(v[j][9]), "+v"(v[j][10]), "+v"(v[j][11]), "+v"(v[j][12]), "+v"(v[j][13]), "+v"(v[j][14]), "+v"(v[j][15]), "+v"(ss)); }
        const float rstd = __builtin_amdgcn_rsqf(wave_sum(ss, lane) * (1.0f / DM) + EPS);
#pragma unroll
        for (int j = 0; j < 2; ++j) { const int c = 16 * (lane + 64 * j);
            if constexpr (LAST) {
#pragma unroll
                for (int q = 0; q < 4; ++q) { const f32x4 nq = *(const f32x4*)(gn + c + 4 * q); f32x4 o;
#pragma unroll
                    for (int e = 0; e < 4; ++e) o[e] = v[j][4 * q + e] * rstd * nq[e];
                    *(f32x4*)((float*)xo + (size_t)row * DM + c + 4 * q) = o; }
            } else { u32x4 x0, x1;
                x0.x = cvt_pk_bf16(v[j][0], v[j][1]); x0.y = cvt_pk_bf16(v[j][2], v[j][3]); x0.z = cvt_pk_bf16(v[j][4], v[j][5]); x0.w = cvt_pk_bf16(v[j][6], v[j][7]);
                x1.x = cvt_pk_bf16(v[j][8], v[j][9]); x1.y = cvt_pk_bf16(v[j][10], v[j][11]); x1.z = cvt_pk_bf16(v[j][12], v[j][13]); x1.w = cvt_pk_bf16(v[j][14], v[j][15]);
                *(u32x4*)((bf16_t*)xo + (size_t)row * DM + c) = x0; *(u32x4*)((bf16_t*)xo + (size_t)row * DM + c + 8) = x1; }
            if constexpr (!LAST) { float r[16];
#pragma unroll
                for (int q = 0; q < 4; ++q) { const f32x4 nq = *(const f32x4*)(gn + c + 4 * q), sq = *(const f32x4*)(scn + (size_t)b * DM + c + 4 * q), hq = *(const f32x4*)(shn + (size_t)b * DM + c + 4 * q);
#pragma unroll
                    for (int e = 0; e < 4; ++e) r[4 * q + e] = v[j][4 * q + e] * rstd * nq[e] * sq[e] + hq[e]; }
                u32x4 h0; h0.x = pg8::pk4_fp8(r[0], r[1], r[2], r[3]); h0.y = pg8::pk4_fp8(r[4], r[5], r[6], r[7]); h0.z = pg8::pk4_fp8(r[8], r[9], r[10], r[11]); h0.w = pg8::pk4_fp8(r[12], r[13], r[14], r[15]);
                *(u32x4*)(H8 + (size_t)row * DM + c) = h0; }
            asm volatile("" ::: "memory"); }
    }
}
__device__ __forceinline__ void ph_build(unsigned* gcnt, unsigned* ntiles, const int* ts_e, const int* ts_r, const float* ts_w, int* rowtok, int* rowdst, float* roww, int* tile_e, LAS unsigned char* lds, int blk, int nblk, const int tid) {
    LAS int* cnt = (LAS int*)lds; LAS int* poff = cnt + 64;
    if (tid < 64) cnt[tid] = (int)__hip_atomic_load(gcnt + tid, __ATOMIC_RELAXED, __HIP_MEMORY_SCOPE_AGENT);
    __syncthreads();
    if (tid == 0) { int o = 0; for (int e = 0; e < 64; ++e) { poff[e] = o; o += (cnt[e] + 255) & ~255; } poff[64] = o; }
    __syncthreads();
    if (blk == 0 && tid == 0) __hip_atomic_store(ntiles, (unsigned)(poff[64] >> 8), __ATOMIC_RELAXED, __HIP_MEMORY_SCOPE_AGENT);
    for (size_t ts = (size_t)blk * 512 + tid; ts < (size_t)NSLOT; ts += (size_t)nblk * 512) { const int e = ts_e[ts], row = poff[e] + ts_r[ts]; rowtok[row] = (int)(ts / TOPK); rowdst[row] = (int)ts; roww[row] = ts_w[ts]; }
    for (int e = blk; e < 64; e += nblk) {
        const int p0 = poff[e], c = cnt[e], p1 = poff[e + 1];
        for (int r = p0 + c + tid; r < p1; r += 512) { rowtok[r] = 0; rowdst[r] = -1; roww[r] = 0.f; }
        for (int t = (p0 >> 8) + tid; t < (p1 >> 8); t += 512) tile_e[t] = e;
    }
}

constexpr int NPHASE = 19;
__host__ __device__ constexpr int phid(int k) { return k < 3 ? k : 3 + (k - 3) % 8; }
typedef const __attribute__((address_space(4))) char* kptr_t;
__device__ __forceinline__ kptr_t kargs() { kptr_t p = (kptr_t)__builtin_amdgcn_kernarg_segment_ptr(); asm volatile("" : "+s"(p)); return p; }
__device__ __forceinline__ const float* karg_in(kptr_t kp, int i) { return *(const float* const __attribute__((address_space(4)))*)(kp + 8 * i); }
__device__ __forceinline__ float* karg_out(kptr_t kp) { return *(float* const __attribute__((address_space(4)))*)(kp + 248); }
__device__ __forceinline__ int karg_probe(kptr_t kp) { return *(const __attribute__((address_space(4))) int*)(kp + 272); }
__device__ __forceinline__ unsigned char* karg_ws(kptr_t kp) { return *(unsigned char* const __attribute__((address_space(4)))*)(kp + 256); }
__device__ __forceinline__ int opaque_tid(int wave0) { int t; asm volatile("v_mbcnt_lo_u32_b32 %0, -1, 0\n\tv_mbcnt_hi_u32_b32 %0, -1, %0" : "=v"(t)); return wave0 * 64 + t; }

__device__ __forceinline__ int build_tile_table(const unsigned* gcnt, LAS int* tl, LAS unsigned char* lds, const int tid) {
    LAS int* cnt = (LAS int*)lds; LAS int* pre = cnt + 64;
    if (tid < 64) { const int c = (int)__hip_atomic_load(gcnt + tid, __ATOMIC_RELAXED, __HIP_MEMORY_SCOPE_AGENT); cnt[tid] = c < ECAP ? c : ECAP; }
    __syncthreads();
    if (tid == 0) { int o = 0; for (int e = 0; e < 64; ++e) { pre[e] = o; o += (cnt[e] + 255) >> 8; } pre[64] = o; }
    __syncthreads();
    const int total = pre[64];
    for (int i = tid; i < total; i += 512) { int e = 0;
#pragma unroll 1
        for (int s2 = 32; s2 >= 1; s2 >>= 1) if (pre[e + s2] <= i) e += s2;
        const int t = i - pre[e], nv = cnt[e] - t * 256; tl[i] = (int)(((unsigned)e << 26) | ((unsigned)t << 16) | (unsigned)(nv < 256 ? nv : 256)); }
    __syncthreads();
    return __builtin_amdgcn_readfirstlane(total);
}

#define ONE_LAUNCH (MASK == 0x7FFu)
#define IN(k) (((MASK >> phid(k)) & 1u) != 0u && (ONE_LAUNCH || (lo <= (k) && (k) < hi)))
#define REPS(id) ((((unsigned)REP_MASK >> (id)) & 1u) ? 2 : 1)
#ifndef BAR_REPS
#define BAR_REPS 1
#endif
#define SEAM(k) do { if (ONE_LAUNCH && (k) + 1 < NPHASE && IN(k) && IN((k) + 1)) { xcd_barrier(bar, opaque_tid(wave0)); if (BAR_REPS > 1) xcd_barrier(bar, opaque_tid(wave0)); if (BAR_REPS > 2) xcd_barrier(bar, opaque_tid(wave0)); } } while (0)
#define PHASE_VIEW() kptr_t kp = kargs(); unsigned char* ws = karg_ws(kp); (void)ws; const int tid = opaque_tid(wave0), lane = tid & 63, wave = __builtin_amdgcn_readfirstlane(tid >> 6); \
        int blk_ = blockIdx.x, G_ = gridDim.x; LAS unsigned char* lds = lds0; asm volatile("" : "+s"(blk_), "+s"(G_), "+s"(lds)); const int blk = blk_, G = G_; \
        const int gw = blk * 8 + wave, ngw = G * 8, gtid = blk * 512 + tid, ngt = G * 512; (void)lane; (void)gw; (void)ngw; (void)gtid; (void)ngt


template <int l, unsigned MASK> __device__ __forceinline__ void layer_body(const int lo, const int hi, const XcdBarrier& bar, const int wave0, LAS unsigned char* const lds0) {
        const int pb = 3 + 8 * l;
#define MF(j) ((const float*)(ws + WS_MODF) + ((size_t)l * 6 + (j)) * NB * DM)
#define CV_CALL(L, FIRST, STRIDE, LO, HI) conv_range(karg_in(kp, I_EW1), karg_in(kp, I_EW3), karg_in(kp, I_EW2), L, ws + WS_WE13, ws + ((L) == 0 ? WS_WE2 : WS_WE2B), (LAS float*)(lds + wave * 16384), FIRST, STRIDE, LO, HI, lane)
#define CV_HOST(ON, NCV, L, LO, HI) const int Gg = G - ((ON) ? (NCV) : 0); if ((ON) && blk >= Gg) { if (!(PROBE_N > 0 && karg_probe(kp) == 9)) CV_CALL(L, (blk - Gg) * 8 + wave, (NCV) * 8, LO, HI); continue; } if (PROBE_N > 0 && karg_probe(kp) == 10) continue;
        if (IN(pb + 0)) for (int rep_ = 0; rep_ < REPS(phid(pb + 0)); ++rep_) { if (rep_) __syncthreads(); PHASE_VIEW();
            const int N = l == 0 ? 3072 : 5120;
            const int ncv_ = l == 0 ? NCV_IN : NCV_IN1, clo_ = l == 0 ? CVQ_P0 : CVQ_C, chi_ = l == 0 ? CVQ_A1 : CV_N13;
            CV_HOST(true, ncv_, l, clo_, chi_)
            pg8::StaticOrder S; S.init(ws + WS_H8, ws + (l == 0 ? WS_WABIN : WS_WCDIN), DM, NTOK, N, Gg, blk, 1);
            if (l == 0) { pg8::EpiBf16 E{(bf16_t*)(ws + WS_P), N, 1.0f / W8_SCALE}; pg8::gemm_phase<pg8::EpiBf16, pg8::StaticOrder, DM, false, 1, true>(lds, S, E, tid); }
            else { pg8::EpiCdIn E{(bf16_t*)(ws + WS_P), 1.0f / W8_SCALE}; pg8::gemm_phase<pg8::EpiCdIn, pg8::StaticOrder, DM, false, 1, true>(lds, S, E, tid); }
        }
        SEAM(pb + 0);
        if (IN(pb + 1)) for (int rep_ = 0; rep_ < REPS(phid(pb + 1)); ++rep_) { if (rep_) __syncthreads(); PHASE_VIEW();
            if (l == 0) ph_mixer_ab((const bf16_t*)(ws + WS_P), ws + WS_Y, (const bf16_t*)(ws + WS_WSGU), karg_in(kp, I_SGUB), karg_in(kp, I_SGULNG), karg_in(kp, I_SGULNB), (const bf16_t*)(ws + WS_WPOOL), karg_in(kp, I_POOLSC), lds, blk, G, tid);
            else ph_mixer_cd((const bf16_t*)(ws + WS_P), ws + WS_Y, karg_in(kp, I_C3W), karg_in(kp, I_C3B), karg_in(kp, I_C31W), karg_in(kp, I_C31B), karg_in(kp, I_CDLNG), karg_in(kp, I_CDLNB), lds, blk, G, tid);
        }
        SEAM(pb + 1);
        if (IN(pb + 2)) for (int rep_ = 0; rep_ < REPS(phid(pb + 2)); ++rep_) { if (rep_) __syncthreads(); PHASE_VIEW();
            CV_HOST(l == 0, NCV_OUT, 0, CVQ_A1, CV_TOT)
            pg8::StaticOrder S; S.init(ws + WS_Y, ws + (l == 0 ? WS_WABOUT : WS_WCDOUT), DM, NTOK, DM, Gg, blk, 1);
            const float oscl = 1.0f / (pg8::Y8M_SCALE * W8_SCALE);
            bf16_t* outp = ((REPS(phid(pb + 2)) == 2 && rep_ == 0) || (PROBE_N > 0 && karg_probe(kp))) ? (bf16_t*)(ws + WS_P) : (bf16_t*)(ws + WS_XB);
            if (l == 0) { pg8::EpiResGate<true> E{karg_in(kp, I_X), outp, MF(2), PROBE_N > 0 ? karg_probe(kp) : 0, oscl}; pg8::gemm_phase<pg8::EpiResGate<true>, pg8::StaticOrder, DM, false, 1, true>(lds, S, E, tid); }
            else { pg8::EpiResGate<false> E{(const void*)(ws + WS_XB), outp, MF(2), PROBE_N > 0 ? karg_probe(kp) : 0, oscl}; pg8::gemm_phase<pg8::EpiResGate<false>, pg8::StaticOrder, DM, false, 1, true>(lds, S, E, tid); }
        }
        SEAM(pb + 2);
        if (IN(pb + 3)) { PHASE_VIEW();
            ph_norm_route((const bf16_t*)(ws + WS_XB), karg_in(kp, I_NFFNG) + l * DM, MF(4), MF(3), (const bf16_t*)(ws + WS_WRS) + (size_t)l * NB * NE * DM, (const float*)(ws + WS_CBP) + (size_t)l * NB * 8 * NE, karg_in(kp, I_RB) + l * NE,
                          (unsigned*)(ws + WS_CTL) + CW_GCNT + l * 64 + ((PROBE_N > 0 && karg_probe(kp)) ? 512 : 0), (int*)(ws + RT_ROWTOK), (int*)(ws + RT_ROWDST), (float*)(ws + RT_ROWW), lds, blk, G, tid, PROBE_N > 0 ? karg_probe(kp) : 0, (unsigned char*)(ws + WS_H8)); }
        SEAM(pb + 3);
        if (IN(pb + 5)) for (int rep_ = 0; rep_ < REPS(phid(pb + 5)); ++rep_) { if (rep_) __syncthreads(); PHASE_VIEW();
            CV_HOST(l == 0, NCV_E1, 1, CV_N13, CV_TOT)
            LAS int* tl = (LAS int*)(lds + SIDE_TILEE);
            const int mt = build_tile_table((const unsigned*)(ws + WS_CTL) + CW_GCNT + l * 64, tl, lds, tid);
            { typedef pg8::ExpertOrder<256 * DM, 768 * DM, 3, true> EO1;
              EO1 S{(const char*)(ws + WS_H8), (const char*)(ws + WS_WE13), tl, (const int*)(ws + RT_ROWTOK), (const int*)(ws + RT_ROWTOK), mt * 3, Gg, blk};
              pg8::EpiSiluMul8 E{(unsigned char*)(ws + WS_ACT), 512, 1.0f / W8_SCALE, -1, 0};
              pg8::gemm_phase<pg8::EpiSiluMul8, EO1, DM, true, 1>(lds, S, E, tid); }
            { PHASE_VIEW();
              const int sh_ = ((((mt * 3) % Gg) + 7) & ~7) % Gg, c2_ = (blk - sh_ + Gg) % Gg;
              pg8::StaticOrder S; S.init(ws + WS_H8, ws + WS_WSH1F8 + (size_t)l * 1024 * DM, DM, NTOK, 1024, Gg, c2_, 1);
              pg8::EpiSiluMul8 E{(unsigned char*)(ws + WS_SACT), SFF, 1.0f / W8_SCALE, -1, 0};
              pg8::gemm_phase<pg8::EpiSiluMul8, pg8::StaticOrder, DM, false, 1>(lds, S, E, tid); }
        }
        SEAM(pb + 5);
        if (IN(pb + 6)) for (int rep_ = 0; rep_ < REPS(phid(pb + 6)); ++rep_) { if (rep_) __syncthreads(); PHASE_VIEW();
            const int Gg = G;
            LAS int* tl = (LAS int*)(lds + SIDE_TILEE);
            const int mt = build_tile_table((const unsigned*)(ws + WS_CTL) + CW_GCNT + l * 64, tl, lds, tid);
            { typedef pg8::ExpertOrder<256 * 512, DM * 512, 8, false> EO2;
              EO2 S{(const char*)(ws + WS_ACT), (const char*)(ws + (l == 0 ? WS_WE2 : WS_WE2B)), tl, (const int*)(ws + RT_ROWDST), (const int*)(ws + RT_ROWW), mt * 8, Gg, blk};
              pg8::EpiScatterY E{(unsigned char*)(ws + WS_YBUF), pg8::Y8_SCALE / (pg8::A8_SCALE * W8_SCALE), PROBE_N > 0 ? karg_probe(kp) : 0};
              pg8::gemm_phase<pg8::EpiScatterY, EO2, 512, false, 1, true, 0, 0, true>(lds, S, E, tid); }
            { PHASE_VIEW();
              const int sh_ = ((((mt * 8) % Gg) + 7) & ~7) % Gg, c2_ = (blk - sh_ + Gg) % Gg;
              pg8::StaticOrder S; S.init(ws + WS_SACT, ws + WS_WSH2F8 + (size_t)l * DM * SFF, SFF, NTOK, DM, Gg, c2_, 1);
              pg8::EpiFp8 E{(unsigned char*)(ws + WS_SHOUT), DM, pg8::Y8_SCALE / (pg8::A8_SCALE * W8_SCALE)};
              pg8::gemm_phase<pg8::EpiFp8, pg8::StaticOrder, SFF, false, 1, true>(lds, S, E, tid); }
        }
        SEAM(pb + 6);
        if (IN(pb + 7)) { PHASE_VIEW();
            if (l == 0) {
                ph_combine_norm<false>((const bf16_t*)(ws + WS_XB), (void*)(ws + WS_XB), (const unsigned char*)(ws + WS_YBUF), (const unsigned char*)(ws + WS_SHOUT), MF(5), karg_in(kp, I_NMIXG) + DM,
                                       (const float*)(ws + WS_MODF) + (size_t)(6 + 1) * NB * DM, (const float*)(ws + WS_MODF) + (size_t)(6 + 0) * NB * DM, (unsigned char*)(ws + WS_H8), gw, ngw, lane);
                CV_CALL(1, gw, ngw, 0, CVQ_C);
            } else {
                ph_combine_norm<true>((const bf16_t*)(ws + WS_XB), (PROBE_N > 0 && karg_probe(kp)) ? (void*)(ws + WS_WE13) : (void*)karg_out(kp), (const unsigned char*)(ws + WS_YBUF), (const unsigned char*)(ws + WS_SHOUT), MF(5), karg_in(kp, I_FG), nullptr, nullptr, nullptr, gw, ngw, lane);
            }
        }
        SEAM(pb + 7);
}

template <unsigned MASK> __global__ void __launch_bounds__(512, 2) mk_fwd(Args) {
    extern __shared__ __attribute__((aligned(16))) unsigned char lds_raw[];
    LAS unsigned char* lds0 = (LAS unsigned char*)lds_raw;
    volatile LAS unsigned* MISC = (volatile LAS unsigned*)(lds0 + MISC_OFF);
    int lo, hi;
    const int wave0 = __builtin_amdgcn_readfirstlane((int)threadIdx.x >> 6);
    XcdBarrier bar;
    { kptr_t kp = kargs(); lo = *(const __attribute__((address_space(4))) int*)(kp + 264); hi = *(const __attribute__((address_space(4))) int*)(kp + 268);
      unsigned* ctl = (unsigned*)(karg_ws(kp) + WS_CTL);
      const int t0 = opaque_tid(wave0);
      if (t0 < 64) MISC[t0] = 0u;
      __syncthreads();
      bar.bar = ctl + CW_BAR; bar.x = 0; bar.st = nullptr;
      if (ONE_LAUNCH) bar = xcd_barrier_post(ctl + CW_BAR, MISC + 8, t0); }
    if (IN(0)) for (int rep_ = 0; rep_ < REPS(phid(0)); ++rep_) { if (rep_) __syncthreads(); PHASE_VIEW();
        if (PROBE_N > 0 && karg_probe(kp) >= 7) {
            const int nb_ = karg_probe(kp) == 7 ? 32 : G;
            if (blk < nb_) conv_range(karg_in(kp, I_EW1), karg_in(kp, I_EW3), karg_in(kp, I_EW2), 0, ws + WS_WE13, ws + WS_WE2, (LAS float*)(lds + wave * 16384), gw, nb_ * 8, 0, CV_TOT, lane);
            continue; }
        ph_mod_partial(karg_in(kp, I_C), karg_in(kp, I_ADAW), (float*)(ws + WS_MODP), lds, blk, G, tid);
        ph_fold_pool(karg_in(kp, I_ABWIN), karg_in(kp, I_POOLW), karg_in(kp, I_POOLSC), ws + WS_WABIN, lds, blk, G, tid);
        ph_convert_misc(kp, ws, (LAS float*)(lds + wave * 16384), gw, ngw, lane, gtid, ngt);
        conv_range(karg_in(kp, I_EW1), karg_in(kp, I_EW3), karg_in(kp, I_EW2), 0, ws + WS_WE13, ws + WS_WE2, (LAS float*)(lds + wave * 16384), gw, ngw, 0, CVQ_P0, lane);
    }
    SEAM(0);
    if (IN(1)) for (int rep_ = 0; rep_ < REPS(phid(1)); ++rep_) { if (rep_) __syncthreads(); PHASE_VIEW(); ph_mod_final((const float*)(ws + WS_MODP), karg_in(kp, I_ADAB), (float*)(ws + WS_MODF), gtid, ngt); }
    SEAM(1);

    if (IN(2)) for (int rep_ = 0; rep_ < REPS(phid(2)); ++rep_) { if (rep_) __syncthreads(); PHASE_VIEW();
        ph_norm(karg_in(kp, I_X), karg_in(kp, I_NMIXG), (const float*)(ws + WS_MODF) + 1 * NB * DM, (const float*)(ws + WS_MODF) + 0 * NB * DM, (unsigned char*)(ws + WS_H8), gw, ngw, lane);
        ph_router_prep(karg_in(kp, I_RW), karg_in(kp, I_NFFNG), (const float*)(ws + WS_MODF), (bf16_t*)(ws + WS_WRS), (float*)(ws + WS_CBP), gtid, ngt, gw, ngw, lane); }
    SEAM(2);

    layer_body<0, MASK>(lo, hi, bar, wave0, lds0);
    layer_body<1, MASK>(lo, hi, bar, wave0, lds0);
#undef IN
#undef SEAM
#undef MF
#undef CV_CALL
#undef CV_HOST
#undef PHASE_VIEW
}

typedef void (*KernFn)(Args);
#if N_LAUNCH_MODE == 1 || PROBE_N > 0
static KernFn kern_of_phase(int id) {
    switch (id) {
        case 0: return mk_fwd<1u << 0>; case 1: return mk_fwd<1u << 1>; case 2: return mk_fwd<1u << 2>; case 3: return mk_fwd<1u << 3>; case 4: return mk_fwd<1u << 4>;
        case 5: return mk_fwd<1u << 5>; case 6: return mk_fwd<1u << 6>; case 7: return mk_fwd<1u << 7>; case 8: return mk_fwd<1u << 8>; case 9: return mk_fwd<1u << 9>;
        default: return mk_fwd<1u << 10>;
    }
}
#endif
#if N_LAUNCH_MODE == 0
static KernFn kern_of(int) { return mk_fwd<0x7FFu>; }
constexpr int NKERN = 1;
#else
static KernFn kern_of(int id) { return kern_of_phase(id); }
constexpr int NKERN = 11;
#endif
extern "C" void kernel_launch(void* const* d_in, const int* in_sizes, int n_in, void* d_out, int out_size, void* d_ws, size_t ws_size, hipStream_t stream) {
    static int grid = 0;
    if (grid == 0) {
        if (n_in != 31 || out_size != NTOK * DM || ws_size < WS_END + (REP_MASK ? 256 * MiB : 0)) { fprintf(stderr, "kernel_launch: unexpected shapes/workspace (n_in %d, out %d, ws %zu < %zu)\n", n_in, out_size, ws_size, (size_t)WS_END); grid = -1; return; }
        int dev = 0, cus = 0, per_cu = 0;
        if (hipGetDevice(&dev) != hipSuccess || hipDeviceGetAttribute(&cus, hipDeviceAttributeMultiprocessorCount, dev) != hipSuccess) { grid = -1; return; }
#if PROBE_N > 0
        for (int i = 0; i < 11; ++i) (void)hipFuncSetAttribute((const void*)kern_of_phase(i), hipFuncAttributeMaxDynamicSharedMemorySize, LDS_BYTES);
#endif
        for (int i = 0; i < NKERN; ++i)
            if (hipFuncSetAttribute((const void*)kern_of(i), hipFuncAttributeMaxDynamicSharedMemorySize, LDS_BYTES) != hipSuccess) { fprintf(stderr, "kernel_launch: hipFuncSetAttribute failed\n"); grid = -1; return; }
        if (hipOccupancyMaxActiveBlocksPerMultiprocessor(&per_cu, (const void*)kern_of(0), 512, LDS_BYTES) != hipSuccess || per_cu < 1) fprintf(stderr, "kernel_launch: occupancy query says %d\n", per_cu);
        (void)hipGetLastError();
        grid = cus;
    }
    if (grid < 0) return;
    (void)hipMemsetAsync((char*)d_ws + WS_CTL, 0, CTL_BYTES, stream);
    Args a{};
    for (int i = 0; i < 31; ++i) a.in[i] = (const float*)d_in[i];
    a.out = (float*)d_out; a.ws = (unsigned char*)d_ws;
    if (N_LAUNCH_MODE == 0) {
        a.ph_lo = 0; a.ph_hi = NPHASE;
        hipLaunchKernelGGL(kern_of(0), dim3(grid), dim3(512), LDS_BYTES, stream, a);
    } else {
        for (int p = 0; p < NPHASE; ++p) { a.ph_lo = p; a.ph_hi = p + 1; hipLaunchKernelGGL(kern_of(phid(p)), dim3(grid), dim3(512), LDS_BYTES, stream, a); }
    }
#if PROBE_N > 0
    { const int plist[] = PROBE_LIST; const int pflag[] = PROBE_FLAG;
      for (int i = 0; i < PROBE_N; ++i) { a.probe = pflag[i]; a.ph_lo = plist[i]; a.ph_hi = plist[i] + 1; hipLaunchKernelGGL(kern_of_phase(phid(plist[i])), dim3(grid), dim3(512), LDS_BYTES, stream, a); } }
#endif
}
```
